# Optimizing an MI355X kernel written in HIP

```python
import math
import jax, jax.numpy as jnp
from jax import lax
import numpy as np

D_MODEL = 1024
BATCH = 16
SEQ = 2048
DEPTH = 2

N_A = max(1, DEPTH // 2)
N_B = DEPTH - N_A

D_RNN = 1280
RNN_BLOCKS = 10
RNN_BW = D_RNN // RNN_BLOCKS
CONV_WIDTH = 4
LRU_C = 8.0

N_HEADS = 8
QK_NOPE = 128
QK_ROPE = 64
V_DIM = 128
KV_RANK = 256
Q_RANK = 384
ROPE_THETA = 10000.0
Q_BLOCK = 128
ATTN_SCALE = (QK_NOPE + QK_ROPE) ** -0.5
EPS = 1e-6

kernel_name = "yoco_rglru_mla_hybrid"


def rms_norm(x, g):
    xf = x.astype(jnp.float32)
    y = xf * lax.rsqrt(jnp.mean(xf * xf, axis=-1, keepdims=True) + EPS)
    return (y * g.astype(jnp.float32)).astype(x.dtype)


def rope_tables(seq_len):
    pos = jnp.arange(seq_len, dtype=jnp.float32)
    inv = ROPE_THETA ** (-jnp.arange(0, QK_ROPE, 2, dtype=jnp.float32) / QK_ROPE)
    ang = pos[:, None] * inv[None, :]
    return jnp.cos(ang), jnp.sin(ang)


def apply_rope(x, cos, sin):
    xf = x.astype(jnp.float32)
    x1, x2 = jnp.split(xf, 2, axis=-1)
    out = jnp.concatenate([x1 * cos - x2 * sin, x2 * cos + x1 * sin], axis=-1)
    return out.astype(x.dtype)


def causal_depthwise_conv(x, w, b):
    c = x.shape[-1]
    y = lax.conv_general_dilated(
        x, w[:, None, :].astype(x.dtype), window_strides=(1,),
        padding=[(CONV_WIDTH - 1, 0)], dimension_numbers=("NWC", "WIO", "NWC"),
        feature_group_count=c)
    return y + b


def _lin_combine(left, right):
    a1, b1 = left
    a2, b2 = right
    return a1 * a2, a2 * b1 + b2


def rglru_layer(x, norm_g, w_in, conv_w, conv_b, w_rg, b_rg, w_ig, b_ig, lam, w_out):
    bsz, seq, _ = x.shape
    h = rms_norm(x, norm_g)
    u = h @ w_in
    xb, gate = u[..., :D_RNN], u[..., D_RNN:]
    xb = causal_depthwise_conv(xb, conv_w, conv_b)
    xblk = xb.reshape(bsz, seq, RNN_BLOCKS, RNN_BW)
    r = jax.nn.sigmoid(jnp.einsum("bsnc,ncd->bsnd", xblk, w_rg).reshape(bsz, seq, D_RNN) + b_rg)
    i = jax.nn.sigmoid(jnp.einsum("bsnc,ncd->bsnd", xblk, w_ig).reshape(bsz, seq, D_RNN) + b_ig)
    log_a = -LRU_C * r.astype(jnp.float32) * jax.nn.softplus(-lam.astype(jnp.float32))
    a = jnp.exp(log_a)
    bterm = jnp.sqrt(-jnp.expm1(2.0 * log_a)) * (i * xb).astype(jnp.float32)
    _, hs = lax.associative_scan(_lin_combine, (a, bterm), axis=1)
    y = hs.astype(x.dtype) * jax.nn.silu(gate)
    return y @ w_out


def mla_shared_kv(x_stream, norm_kv, w_dkv, kv_norm, w_uk, w_uv, cos, sin):
    h = rms_norm(x_stream, norm_kv)
    ckr = h @ w_dkv
    c_kv = rms_norm(ckr[..., :KV_RANK], kv_norm)
    k_rope = apply_rope(ckr[..., KV_RANK:], cos[None], sin[None])
    k_nope = jnp.einsum("bsc,chd->bshd", c_kv, w_uk)
    v = jnp.einsum("bsc,chd->bshd", c_kv, w_uv)
    return k_nope, k_rope, v


def causal_block_attention(q_nope, q_rope, k_nope, k_rope, v):
    bsz, seq, nh, _ = q_nope.shape
    nb = seq // Q_BLOCK
    qn = q_nope.reshape(bsz, nb, Q_BLOCK, nh, QK_NOPE).transpose(1, 0, 2, 3, 4)
    qr = q_rope.reshape(bsz, nb, Q_BLOCK, nh, QK_ROPE).transpose(1, 0, 2, 3, 4)
    kpos = jnp.arange(seq)

    def one_block(args):
        qn_b, qr_b, bi = args
        s = jnp.einsum("bqhd,bkhd->bhqk", qn_b, k_nope, preferred_element_type=jnp.float32)
        s = s + jnp.einsum("bqhr,bkr->bhqk", qr_b, k_rope, preferred_element_type=jnp.float32)
        s = s * ATTN_SCALE
        qpos = bi * Q_BLOCK + jnp.arange(Q_BLOCK)
        mask = kpos[None, :] <= qpos[:, None]
        s = jnp.where(mask[None, None], s, -jnp.inf)
        p = jax.nn.softmax(s, axis=-1)
        return jnp.einsum("bhqk,bkhd->bqhd", p.astype(v.dtype), v)

    o = lax.map(one_block, (qn, qr, jnp.arange(nb)))
    return o.transpose(1, 0, 2, 3, 4).reshape(bsz, seq, nh, V_DIM)


def mla_layer(x, norm_g, w_in, q_norm, w_uq, w_out, k_nope, k_rope, v, cos, sin):
    bsz, seq, _ = x.shape
    h = rms_norm(x, norm_g)
    u = h @ w_in
    c_q = rms_norm(u[..., :Q_RANK], q_norm)
    gate = u[..., Q_RANK:]
    q = jnp.einsum("bsc,chd->bshd", c_q, w_uq)
    q_nope = q[..., :QK_NOPE]
    q_rope = apply_rope(q[..., QK_NOPE:], cos[None, :, None], sin[None, :, None])
    o = causal_block_attention(q_nope, q_rope, k_nope, k_rope, v)
    y = o.reshape(bsz, seq, N_HEADS * V_DIM) * jax.nn.silu(gate)
    return y @ w_out


def setup_inputs(seed: int = 0) -> dict:
    key = jax.random.key(seed)
    ks = jax.random.split(key, 24)
    f32 = jnp.float32
    nrm = lambda k, shape, fan_in: jax.random.normal(k, shape, f32) * (fan_in ** -0.5)
    gain = lambda k, shape: 1.0 + 0.02 * jax.random.normal(k, shape, f32)
    small = lambda k, shape: 0.01 * jax.random.normal(k, shape, f32)

    u = jax.random.uniform(ks[8], (N_A, D_RNN), f32, 0.9, 0.999)
    a0 = u ** (1.0 / LRU_C)
    lam = jnp.log(a0) - jnp.log1p(-a0)

    return {
        "x": jax.random.normal(ks[0], (BATCH, SEQ, D_MODEL), f32),
        "norm_a": gain(ks[1], (N_A, D_MODEL)),
        "w_in_a": nrm(ks[2], (N_A, D_MODEL, 2 * D_RNN), D_MODEL),
        "conv_w": nrm(ks[3], (N_A, CONV_WIDTH, D_RNN), CONV_WIDTH),
        "conv_b": small(ks[4], (N_A, D_RNN)),
        "w_rg": nrm(ks[5], (N_A, RNN_BLOCKS, RNN_BW, RNN_BW), RNN_BW),
        "b_rg": small(ks[6], (N_A, D_RNN)),
        "w_ig": nrm(ks[7], (N_A, RNN_BLOCKS, RNN_BW, RNN_BW), RNN_BW),
        "b_ig": small(ks[9], (N_A, D_RNN)),
        "lru_lambda": lam,
        "w_out_a": nrm(ks[10], (N_A, D_RNN, D_MODEL), D_RNN),
        "norm_kv": gain(ks[11], (D_MODEL,)),
        "w_dkv": nrm(ks[12], (D_MODEL, KV_RANK + QK_ROPE), D_MODEL),
        "kv_norm": gain(ks[13], (KV_RANK,)),
        "w_uk": nrm(ks[14], (KV_RANK, N_HEADS, QK_NOPE), KV_RANK),
        "w_uv": nrm(ks[15], (KV_RANK, N_HEADS, V_DIM), KV_RANK),
        "norm_b": gain(ks[16], (N_B, D_MODEL)),
        "w_in_b": nrm(ks[17], (N_B, D_MODEL, Q_RANK + N_HEADS * V_DIM), D_MODEL),
        "q_norm": gain(ks[18], (N_B, Q_RANK)),
        "w_uq": nrm(ks[19], (N_B, Q_RANK, N_HEADS, QK_NOPE + QK_ROPE), Q_RANK),
        "w_out_b": nrm(ks[20], (N_B, N_HEADS * V_DIM, D_MODEL), N_HEADS * V_DIM),
        "final_norm": gain(ks[21], (D_MODEL,)),
    }


def reference(x, norm_a, w_in_a, conv_w, conv_b, w_rg, b_rg, w_ig, b_ig, lru_lambda, w_out_a,
              norm_kv, w_dkv, kv_norm, w_uk, w_uv,
              norm_b, w_in_b, q_norm, w_uq, w_out_b, final_norm):
    seq = x.shape[1]
    cos, sin = rope_tables(seq)
    k_nope = k_rope = v = None
    for layer in range(DEPTH):
        if layer < N_A:
            x = x + rglru_layer(x, norm_a[layer], w_in_a[layer], conv_w[layer], conv_b[layer],
                                w_rg[layer], b_rg[layer], w_ig[layer], b_ig[layer],
                                lru_lambda[layer], w_out_a[layer])
        else:
            if layer == N_A:
                k_nope, k_rope, v = mla_shared_kv(x, norm_kv, w_dkv, kv_norm, w_uk, w_uv, cos, sin)
            j = layer - N_A
            x = x + mla_layer(x, norm_b[j], w_in_b[j], q_norm[j], w_uq[j], w_out_b[j],
                              k_nope, k_rope, v, cos, sin)
    return rms_norm(x, final_norm)
```

```cpp
#include <hip/hip_runtime.h>
#include <hip/hip_cooperative_groups.h>
#include <cstdio>
namespace cg = cooperative_groups;

typedef _Float16 h16;
typedef __attribute__((ext_vector_type(8))) _Float16 h16x8;
typedef __attribute__((ext_vector_type(4))) _Float16 h16x4;
typedef __attribute__((ext_vector_type(16))) float f32x16;
typedef __attribute__((ext_vector_type(4))) unsigned u32x4;

#define DI __device__ __forceinline__
#define MFMA(a, b, c) __builtin_amdgcn_mfma_f32_32x32x16_f16((a), (b), (c), 0, 0, 0)

constexpr int M_TOK = 32768;
constexpr int SEQ = 2048;
constexpr size_t MiB = 1u << 20;
constexpr int LD1K = 1088;
constexpr int LDY = 1344;
constexpr int LDKV = 320;
constexpr size_t OFF_W1T = 0;
constexpr size_t OFF_WRG = 5 * MiB + 512 * 1024;
constexpr size_t OFF_WIG = 6 * MiB;
constexpr size_t OFF_WOA = 6 * MiB + 512 * 1024;
constexpr size_t OFF_W4T = 9 * MiB + 512 * 1024;
constexpr size_t OFF_W5KV = 13 * MiB + 512 * 1024;
constexpr size_t OFF_W5Q = 15 * MiB;
constexpr size_t OFF_WOB = 16 * MiB + 512 * 1024;
constexpr size_t OFF_COS = 19 * MiB;
constexpr size_t OFF_SIN = OFF_COS + 256 * 1024;
constexpr size_t OFF_SSQX1 = 19 * MiB + 512 * 1024;
constexpr size_t OFF_SSQKV = 21 * MiB + 512 * 1024;
constexpr size_t OFF_SSQQ = 22 * MiB;
constexpr size_t OFF_SSQO = 23 * MiB;
constexpr size_t OFF_BAR = 25 * MiB;
constexpr size_t SLOT1 = 26 * MiB;
constexpr size_t SLOT2 = 110 * MiB;
constexpr size_t SLOT3 = 270 * MiB;
constexpr size_t OFF_H0 = SLOT1, OFF_Y = SLOT1, OFF_CKV = SLOT1, OFF_CQ = SLOT1 + 24 * MiB, OFF_Y2 = SLOT1;
constexpr size_t OFF_XB = SLOT2, OFF_SG = SLOT2 + 80 * MiB, OFF_X1H = 436 * MiB  , OFF_Q = SLOT2, OFF_SG2 = SLOT2 + 96 * MiB;
constexpr size_t OFF_X2 = SLOT2;
constexpr size_t OFF_TAGS = 432 * MiB;
constexpr size_t OFF_KF = SLOT3, OFF_VT = SLOT3 + 96 * MiB;

struct Params {
  const float *x, *norm_a, *w_in_a, *conv_w, *conv_b, *w_rg, *b_rg, *w_ig, *b_ig, *lam, *w_out_a;
  const float *norm_kv, *w_dkv, *kv_norm, *w_uk, *w_uv, *norm_b, *w_in_b, *q_norm, *w_uq, *w_out_b, *final_norm;
  float* out;
  unsigned char* ws;
};

DI int crow(int i, int h) { return (i & 3) + 8 * (i >> 2) + 4 * h; }
DI constexpr int crow0(int i) { return (i & 3) + 8 * (i >> 2); }
DI float fexp2(float x) { return __builtin_amdgcn_exp2f(x); }
DI float frcp(float x) { return __builtin_amdgcn_rcpf(x); }
DI float silu_f(float v) { return v * frcp(1.f + fexp2(-1.44269504f * v)); }
DI float wave_sum(float v) {
#pragma unroll
  for (int o = 32; o; o >>= 1) v += __shfl_xor(v, o);
  return v;
}
DI float half_sum32(float v) {
#pragma unroll
  for (int o = 16; o; o >>= 1) v += __shfl_xor(v, o);
  return v;
}
DI int ptid() { int t = __builtin_amdgcn_workitem_id_x(); asm volatile("" : "+v"(t)); return t; }
DI int vblock() { return (blockIdx.x & 7) * (gridDim.x >> 3) + (blockIdx.x >> 3); }
DI int round_item(int k, int n) {
  const int G = gridDim.x, base = k * G;
  if (base + G <= n) return base + vblock();
  const int t = base + (int)blockIdx.x;
  return t < n ? t : -1;
}

DI void transpose_tile(const float* __restrict__ src, int ld, int n_off, h16* __restrict__ dst, int dst_ld, int row_off,
                       const float* __restrict__ gain, int tn, int tk, float* lds) {
  const int tid = ptid();
  const int k0 = tk * 64, n0 = tn * 64;
#pragma unroll
  for (int i = 0; i < 4; i++) {
    const int idx = tid + 256 * i, kk = idx >> 4, n4 = idx & 15;
    const float4 v = *(const float4*)(src + (size_t)(k0 + kk) * ld + n_off + n0 + n4 * 4);
    const float g = gain ? gain[k0 + kk] : 1.f;
    float* d = lds + kk * 65 + n4 * 4;
    d[0] = v.x * g; d[1] = v.y * g; d[2] = v.z * g; d[3] = v.w * g;
  }
  __syncthreads();
#pragma unroll
  for (int i = 0; i < 2; i++) {
    const int idx = tid + 256 * i, nn = idx >> 3, kc = idx & 7;
    h16x8 o;
#pragma unroll
    for (int j = 0; j < 8; j++) o[j] = (h16)lds[(kc * 8 + j) * 65 + nn];
    *(h16x8*)(dst + (size_t)(row_off + n0 + nn) * dst_ld + k0 + kc * 8) = o;
  }
  __syncthreads();
}

DI void phase0(const Params& p, unsigned char* smem) {
  float* lds = (float*)smem;
  unsigned char* ws = p.ws;
  const int tid = ptid(), lane = tid & 63;
  for (int t = blockIdx.x; t < 2000; t += gridDim.x) {
    int u = t;
    if (u < 640) { transpose_tile(p.w_in_a, 2560, 0, (h16*)(ws + OFF_W1T), LD1K, 0, nullptr, u % 40, u / 40, lds); continue; }
    u -= 640;
    if (u < 80) {
      const int which = u / 40, n = (u % 40) >> 2, tn = u & 1, tk = (u >> 1) & 1;
      transpose_tile((which ? p.w_ig : p.w_rg) + n * 16384, 128, 0, (h16*)(ws + (which ? OFF_WIG : OFF_WRG)), 128, n * 128, nullptr, tn, tk, lds);
      continue;
    }
    u -= 80;
    if (u < 320) { transpose_tile(p.w_out_a, 1024, 0, (h16*)(ws + OFF_WOA), LDY, 0, nullptr, u % 16, u / 16, lds); continue; }
    u -= 320;
    if (u < 64) { transpose_tile(p.w_dkv, 320, 0, (h16*)(ws + OFF_W4T), LD1K, 0, p.norm_kv, u % 4, u / 4, lds); continue; }
    u -= 64;
    if (u < 96) { transpose_tile(p.w_in_b, 1408, 0, (h16*)(ws + OFF_W4T), LD1K, 256, p.norm_b, u % 6, u / 6, lds); continue; }
    u -= 96;
    if (u < 256) { transpose_tile(p.w_in_b, 1408, 384, (h16*)(ws + OFF_W4T), LD1K, 640, p.norm_b, u % 16, u / 16, lds); continue; }
    u -= 256;
    if (u < 16) { transpose_tile(p.w_dkv, 320, 256, (h16*)(ws + OFF_W4T), LD1K, 1664, p.norm_kv, 0, u, lds); continue; }
    u -= 16;
    if (u < 64) { transpose_tile(p.w_uk, 1024, 0, (h16*)(ws + OFF_W5KV), LDKV, 0, p.kv_norm, u % 16, u / 16, lds); continue; }
    u -= 64;
    if (u < 64) { transpose_tile(p.w_uv, 1024, 0, (h16*)(ws + OFF_W5KV), LDKV, 1024, p.kv_norm, u % 16, u / 16, lds); continue; }
    u -= 64;
    if (u < 144) { transpose_tile(p.w_uq, 1536, 0, (h16*)(ws + OFF_W5Q), 384, 0, p.q_norm, u % 24, u / 24, lds); continue; }
    u -= 144;
    transpose_tile(p.w_out_b, 1024, 0, (h16*)(ws + OFF_WOB), LD1K, 0, nullptr, u % 16, u / 16, lds);
  }
  {
    u32x4* tz = (u32x4*)(ws + OFF_TAGS);
    for (int e = blockIdx.x * 256 + tid; e < M_TOK * 16 * 8 / 16; e += gridDim.x * 256) tz[e] = (u32x4){0u, 0u, 0u, 0u};
  }
  {
    h16* z = (h16*)(ws + OFF_W4T) + (size_t)1728 * LD1K;
    for (int e = blockIdx.x * 256 + tid; e < 64 * LD1K; e += gridDim.x * 256) z[e] = (h16)0.f;
  }
  {
    float* ct = (float*)(ws + OFF_COS);
    float* st = (float*)(ws + OFF_SIN);
    for (int e = blockIdx.x * 256 + tid; e < SEQ * 32; e += gridDim.x * 256) {
      const int pos = e >> 5, i = e & 31;
      const float inv = powf(10000.f, -(float)(2 * i) / 64.f);
      const float ang = (float)pos * inv;
      const double a = (double)ang;
      const double k = rint(a * 0.15915494309189535);
      const float rr = (float)(a - k * 6.283185307179586);
      ct[e] = cosf(rr);
      st[e] = sinf(rr);
    }
  }
  {
    h16* h0 = (h16*)(ws + OFF_H0);
    const int nwv = gridDim.x * 4;
    const int rpw = (((M_TOK + nwv - 1) / nwv) + 3) & ~3;
    const int rbase = (blockIdx.x * 4 + (tid >> 6)) * rpw;
    float4 g[4];
#pragma unroll
    for (int i = 0; i < 4; i++) g[i] = ((const float4*)p.norm_a)[lane + 64 * i];
    for (int k = 0; k < rpw && rbase + k < M_TOK; k += 4) {
      float4 v[4][4];
#pragma unroll
      for (int u = 0; u < 4; u++) {
        const float4* xr = (const float4*)(p.x + (size_t)(rbase + k + u) * 1024);
#pragma unroll
        for (int i = 0; i < 4; i++) v[u][i] = xr[lane + 64 * i];
      }
#pragma unroll
      for (int u = 0; u < 4; u++) {
        float ss = 0.f;
#pragma unroll
        for (int i = 0; i < 4; i++) ss += v[u][i].x * v[u][i].x + v[u][i].y * v[u][i].y + v[u][i].z * v[u][i].z + v[u][i].w * v[u][i].w;
        ss = wave_sum(ss);
        const float rinv = rsqrtf(ss * (1.f / 1024.f) + 1e-6f);
#pragma unroll
        for (int i = 0; i < 4; i++) {
          h16x4 o;
          o[0] = (h16)(v[u][i].x * rinv * g[i].x);
          o[1] = (h16)(v[u][i].y * rinv * g[i].y);
          o[2] = (h16)(v[u][i].z * rinv * g[i].z);
          o[3] = (h16)(v[u][i].w * rinv * g[i].w);
          *(h16x4*)(h0 + (size_t)(rbase + k + u) * LD1K + (lane + 64 * i) * 4) = o;
        }
      }
    }
  }
}

constexpr int LROW = 144;
constexpr int MI = 4;
constexpr int GEMM_LDS = 384 * LROW;
template <bool SWAP, bool PIN = false>
DI void gemm_mainloop(const h16* __restrict__ A, int lda, const h16* __restrict__ Bt, int ldb, int K, int m0, int n0,
                      unsigned char* smem, f32x16 (&acc)[MI][2], int kstart = 0) {
  const int tid = ptid(), lane = tid & 63, w = tid >> 6;
  const int r = lane & 31, h = lane >> 5;
  const int wm = w >> 1, wn = w & 1;
  const int seg = tid & 7, lrow = tid >> 3;
  const unsigned char* Ab = (const unsigned char*)(A + (size_t)m0 * lda);
  const unsigned char* Bb = (const unsigned char*)(Bt + (size_t)n0 * ldb);
  const unsigned offa0 = (unsigned)(lrow * lda + seg * 8) * 2u, offb0 = (unsigned)(lrow * ldb + seg * 8) * 2u;
  int kcur = kstart;
  unsigned offa = offa0 + (unsigned)kcur * 128u, offb = offb0 + (unsigned)kcur * 128u;
  u32x4 st[12];
#pragma unroll
  for (int i = 0; i < 8; i++) st[i] = *(const u32x4*)(Ab + (size_t)i * 64 * lda + offa);
#pragma unroll
  for (int i = 0; i < 4; i++) st[8 + i] = *(const u32x4*)(Bb + (size_t)i * 64 * ldb + offb);
#pragma unroll
  for (int mi = 0; mi < MI; mi++)
#pragma unroll
    for (int ni = 0; ni < 2; ni++)
#pragma unroll
      for (int i = 0; i < 16; i++) acc[mi][ni][i] = 0.f;
  const int nk = K >> 6;
  unsigned char* wA = smem + lrow * LROW + seg * 16;
  const unsigned char* rA = smem + (wm * 128 + r) * LROW + h * 16;
  const unsigned char* rB = smem + (256 + wn * 64 + r) * LROW + h * 16;
  for (int kt = 0; kt < nk; kt++) {
#pragma unroll
    for (int i = 0; i < 12; i++) *(u32x4*)(wA + i * 32 * LROW) = st[i];
    __syncthreads();
    if (kt + 1 < nk) {
      kcur = (kcur + 1 == nk) ? 0 : kcur + 1;
      offa = offa0 + (unsigned)kcur * 128u;
      offb = offb0 + (unsigned)kcur * 128u;
#pragma unroll
      for (int i = 0; i < 8; i++) st[i] = *(const u32x4*)(Ab + (size_t)i * 64 * lda + offa);
#pragma unroll
      for (int i = 0; i < 4; i++) st[8 + i] = *(const u32x4*)(Bb + (size_t)i * 64 * ldb + offb);
    }
    if (PIN) __builtin_amdgcn_sched_barrier(0);
#pragma unroll
    for (int ks = 0; ks < 4; ks++) {
      h16x8 af[MI], bf[2];
#pragma unroll
      for (int mi = 0; mi < MI; mi++) af[mi] = *(const h16x8*)(rA + mi * 32 * LROW + ks * 32);
      bf[0] = *(const h16x8*)(rB + ks * 32);
      bf[1] = *(const h16x8*)(rB + 32 * LROW + ks * 32);
#pragma unroll
      for (int mi = 0; mi < MI; mi++)
#pragma unroll
        for (int ni = 0; ni < 2; ni++)
          acc[mi][ni] = SWAP ? MFMA(bf[ni], af[mi], acc[mi][ni]) : MFMA(af[mi], bf[ni], acc[mi][ni]);
    }
    __syncthreads();
  }
}


constexpr int STG_ROW = 144;
constexpr int STG_WAVE = 64 * STG_ROW;
DI void stage_put(unsigned char* wl, int r, int h, int ni, int gi, h16x4 o) {
  *(h16x4*)(wl + r * STG_ROW + (ni * 32 + 8 * gi + 4 * h) * 2) = o;
}
DI void stage_fence() {
  __builtin_amdgcn_fence(__ATOMIC_ACQ_REL, "wavefront");
  __builtin_amdgcn_wave_barrier();
}
DI void stage_flush(const unsigned char* wl, int lane, h16* grow0, size_t ld) {
  stage_fence();
#pragma unroll
  for (int k = 0; k < 4; k++) {
    const int idx = lane + 64 * k, row = idx >> 3, seg = idx & 7;
    const u32x4 v = *(const u32x4*)(wl + row * STG_ROW + seg * 16);
    *(u32x4*)(grow0 + (size_t)row * ld + seg * 8) = v;
  }
  stage_fence();
}

DI void phase1(const Params& p, unsigned char* smem) {
  unsigned char* ws = p.ws;
  const h16* A = (const h16*)(ws + OFF_H0);
  const h16* Bt = (const h16*)(ws + OFF_W1T);
  h16* xb = (h16*)(ws + OFF_XB);
  h16* sg = (h16*)(ws + OFF_SG);
  const int lane = ptid() & 63, w = ptid() >> 6, r = lane & 31, h = lane >> 5, wm = w >> 1, wn = w & 1;
  for (int t = vblock(); t < 128 * 20; t += gridDim.x) {
    const int m0 = (t / 20) * 256, n0 = (t % 20) * 128;
    f32x16 acc[MI][2];
    const int nb = n0 + wn * 64;
    if (n0 >= 1280) {
      gemm_mainloop<false>(A, LD1K, Bt, LD1K, 1024, m0, n0, smem, acc, (t * 5) & 15);
#pragma unroll
      for (int mi = 0; mi < MI; mi++)
#pragma unroll
        for (int ni = 0; ni < 2; ni++) {
          const int tb = (m0 + wm * 128 + mi * 32) >> 5, cb = (nb - 1280 + ni * 32) >> 5;
          h16x8 v0, v1;
#pragma unroll
          for (int i = 0; i < 8; i++) {
            v0[i] = (h16)silu_f(acc[mi][ni][i]);
            v1[i] = (h16)silu_f(acc[mi][ni][8 + i]);
          }
          h16* d = sg + (((size_t)tb * 40 + cb) * 64 + lane) * 16;
          *(h16x8*)d = v0;
          *(h16x8*)(d + 8) = v1;
        }
    } else {
      gemm_mainloop<true>(A, LD1K, Bt, LD1K, 1024, m0, n0, smem, acc, (t * 5) & 15);
      unsigned char* wl = smem + w * STG_WAVE;
#pragma unroll
      for (int mi = 0; mi < MI; mi++) {
#pragma unroll
        for (int ni = 0; ni < 2; ni++)
#pragma unroll
          for (int gi = 0; gi < 4; gi++) {
            h16x4 o;
#pragma unroll
            for (int j = 0; j < 4; j++) o[j] = (h16)acc[mi][ni][gi * 4 + j];
            stage_put(wl, r, h, ni, gi, o);
          }
        stage_flush(wl, lane, xb + (size_t)(m0 + wm * 128 + mi * 32) * 1280 + nb, 1280);
      }
    }
    __syncthreads();
  }
}

DI void phase2(const Params& p, unsigned char* smem) {
  unsigned char* ws = p.ws;
  const h16* xb = (const h16*)(ws + OFF_XB);
  const h16* sg = (const h16*)(ws + OFF_SG);
  h16* y = (h16*)(ws + OFF_Y);
  const h16* Wrg = (const h16*)(ws + OFF_WRG);
  const h16* Wig = (const h16*)(ws + OFF_WIG);
  h16* As = (h16*)smem;
  h16* cw_s = (h16*)(smem + 34816);
  h16* cb_s = (h16*)(smem + 36864);
  float* agg = (float*)(smem + 37376);
  h16* Ys = (h16*)(smem + 38400);
  const int tid = ptid(), lane = tid & 63, w = tid >> 6, r = lane & 31, h = lane >> 5;
  const float L2E = 1.44269504f;
  for (int rk = 0; rk * (int)gridDim.x < 640; rk++) {
    const int it = round_item(rk, 640);
    if (it < 0) break;
    const int b = it / 40, n = (it % 40) >> 2, q = it & 3;
    __syncthreads();
    if (tid < 128) {
      cb_s[tid] = (h16)p.conv_b[n * 128 + tid];
#pragma unroll
      for (int k = 0; k < 4; k++) cw_s[k * 128 + tid] = (h16)p.conv_w[k * 1280 + n * 128 + tid];
    }
    h16x8 brg[8], big[8];
    {
      const h16* wr = Wrg + (size_t)(n * 128 + q * 32 + r) * 128 + h * 8;
      const h16* wi = Wig + (size_t)(n * 128 + q * 32 + r) * 128 + h * 8;
#pragma unroll
      for (int ks = 0; ks < 8; ks++) {
        brg[ks] = *(const h16x8*)(wr + ks * 16);
        big[ks] = *(const h16x8*)(wi + ks * 16);
      }
    }
    const int ch = n * 128 + q * 32 + r;
    const float cbr = -L2E * p.b_rg[ch], cbi = -L2E * p.b_ig[ch];
    const float cch2 = -8.f * L2E * log1pf(expf(-p.lam[ch]));
    float hc = 0.f;
    const int cgp = tid & 15, rgp = tid >> 4;
    const h16* src = xb + ((size_t)(b * SEQ) + rgp * 8 - 3) * 1280 + n * 128 + cgp * 8;
    u32x4 xin[11];
#pragma unroll
    for (int j = 0; j < 11; j++) {
      if (rgp == 0 && j < 3) xin[j] = (u32x4){0u, 0u, 0u, 0u};
      else xin[j] = *(const u32x4*)(src + (ptrdiff_t)j * 1280);
    }
    __syncthreads();
    for (int c = 0; c < 16; c++) {
      {
        const h16x8 w0 = *(const h16x8*)(cw_s + 0 * 128 + cgp * 8), w1 = *(const h16x8*)(cw_s + 1 * 128 + cgp * 8);
        const h16x8 w2 = *(const h16x8*)(cw_s + 2 * 128 + cgp * 8), w3 = *(const h16x8*)(cw_s + 3 * 128 + cgp * 8);
        const h16x8 bb = *(const h16x8*)(cb_s + cgp * 8);
#pragma unroll
        for (int o = 0; o < 8; o++) {
          h16x8 a = w0 * __builtin_bit_cast(h16x8, xin[o]) + bb;
          a = w1 * __builtin_bit_cast(h16x8, xin[o + 1]) + a;
          a = w2 * __builtin_bit_cast(h16x8, xin[o + 2]) + a;
          a = w3 * __builtin_bit_cast(h16x8, xin[o + 3]) + a;
          *(h16x8*)(As + (rgp * 8 + o) * 136 + cgp * 8) = a;
        }
      }
      __syncthreads();
      if (c + 1 < 16) {
        const h16* s2 = src + (size_t)(c + 1) * 128 * 1280;
#pragma unroll
        for (int j = 0; j < 11; j++) xin[j] = *(const u32x4*)(s2 + (ptrdiff_t)j * 1280);
      }
      __builtin_amdgcn_sched_barrier(0);
      const int tb = (b * SEQ + c * 128 + w * 32) >> 5, cbk = n * 4 + q;
      const h16* sgp = sg + (((size_t)tb * 40 + cbk) * 64 + lane) * 16;
      const h16x8 sg0 = *(const h16x8*)sgp, sg1 = *(const h16x8*)(sgp + 8);
      f32x16 ar, ai;
#pragma unroll
      for (int i = 0; i < 16; i++) { ar[i] = 0.f; ai[i] = 0.f; }
      {
        const unsigned char* rA = (const unsigned char*)As + (w * 32 + r) * 272 + h * 16;
#pragma unroll
        for (int ks = 0; ks < 8; ks++) {
          const h16x8 a = *(const h16x8*)(rA + ks * 32);
          ar = MFMA(a, brg[ks], ar);
          ai = MFMA(a, big[ks], ai);
        }
      }
      float P[16], H[16], SA[4], SB[4];
#pragma unroll
      for (int gi = 0; gi < 4; gi++) {
        float pp = 1.f, hh = 0.f;
#pragma unroll
        for (int j = 0; j < 4; j++) {
          const int i = gi * 4 + j;
          const int tok = w * 32 + 8 * gi + 4 * h + j;
          const float xc = (float)As[tok * 136 + q * 32 + r];
          const float a1 = fminf(fmaf(ar[i], -L2E, cbr), 60.f), a2 = fminf(fmaf(ai[i], -L2E, cbi), 60.f);
          const float t1 = 1.f + fexp2(a1), t2 = 1.f + fexp2(a2);
          const float inv = frcp(t1 * t2);
          const float rs = t2 * inv, is = t1 * inv;
          const float a = fexp2(cch2 * rs);
          const float om = fmaf(-a, a, 1.f);
          const float bt = __builtin_amdgcn_sqrtf(om) * is * xc;
          hh = a * hh + bt;
          pp = a * pp;
          P[i] = pp;
          H[i] = hh;
        }
        SA[gi] = pp;
        SB[gi] = hh;
      }
      float CA = 1.f, CB = 0.f, inA[4], inB[4];
#pragma unroll
      for (int gi = 0; gi < 4; gi++) {
        const float oa = __shfl_xor(SA[gi], 32), ob = __shfl_xor(SB[gi], 32);
        const float a0 = h ? oa : SA[gi], b0 = h ? ob : SB[gi];
        const float a1 = h ? SA[gi] : oa, b1 = h ? SB[gi] : ob;
        const float ca0 = CA, cb0 = CB;
        CB = a0 * CB + b0;
        CA = a0 * CA;
        inA[gi] = h ? CA : ca0;
        inB[gi] = h ? CB : cb0;
        CB = a1 * CB + b1;
        CA = a1 * CA;
      }
      if (h == 0) {
        agg[(w * 32 + r) * 2] = CA;
        agg[(w * 32 + r) * 2 + 1] = CB;
      }
      __syncthreads();
      float hin = hc, hrun = hc;
#pragma unroll
      for (int w2 = 0; w2 < 4; w2++) {
        const float a = agg[(w2 * 32 + r) * 2], bb = agg[(w2 * 32 + r) * 2 + 1];
        if (w2 == w) hin = hrun;
        hrun = a * hrun + bb;
      }
      hc = hrun;
#pragma unroll
      for (int gi = 0; gi < 4; gi++) {
        const float hs = inA[gi] * hin + inB[gi];
#pragma unroll
        for (int j = 0; j < 4; j++) {
          const int i = gi * 4 + j;
          const int tok = w * 32 + 8 * gi + 4 * h + j;
          const float hv = H[i] + P[i] * hs;
          const float g = (float)(i < 8 ? sg0[i & 7] : sg1[i & 7]);
          Ys[tok * 40 + r] = (h16)(hv * g);
        }
      }
      __syncthreads();
#pragma unroll
      for (int k = 0; k < 2; k++) {
        const int idx = tid + 256 * k, row = idx >> 2, seg = idx & 3;
        *(u32x4*)(y + ((size_t)(b * SEQ + c * 128 + row)) * LDY + n * 128 + q * 32 + seg * 8) = *(const u32x4*)(Ys + row * 40 + seg * 8);
      }
    }
  }
}

DI void phase_res_gemm(const h16* __restrict__ A, int ld, int K, const h16* __restrict__ Bt, const float* __restrict__ res, float* __restrict__ outp, h16* __restrict__ outh, float* __restrict__ ssq,
                       unsigned char* smem) {
  const int lane = ptid() & 63, w = ptid() >> 6, r = lane & 31, h = lane >> 5, wm = w >> 1, wn = w & 1;
  for (int t = vblock(); t < 128 * 8; t += gridDim.x) {
    const int m0 = (t >> 3) * 256, n0 = (t & 7) * 128;
    f32x16 acc[MI][2];
    gemm_mainloop<true>(A, ld, Bt, ld, K, m0, n0, smem, acc);
    const int nb = n0 + wn * 64;
    unsigned char* wl = smem + w * STG_WAVE;
#pragma unroll
    for (int mi = 0; mi < MI; mi++) {
      const int rowb = m0 + wm * 128 + mi * 32;
      const int row = rowb + r;
#pragma unroll
      for (int k = 0; k < 8; k++) {
        const int idx = lane + 64 * k, rr = idx >> 4, sg4 = idx & 15;
        *(float4*)(wl + rr * 272 + sg4 * 16) = *(const float4*)(res + (size_t)(rowb + rr) * 1024 + nb + sg4 * 4);
      }
      stage_fence();
      float sq = 0.f;
      h16x4 ov[2][4];
#pragma unroll
      for (int ni = 0; ni < 2; ni++)
#pragma unroll
        for (int gi = 0; gi < 4; gi++) {
          float4 v = *(const float4*)(wl + r * 272 + (ni * 32 + 8 * gi + 4 * h) * 4);
          v.x += acc[mi][ni][gi * 4 + 0];
          v.y += acc[mi][ni][gi * 4 + 1];
          v.z += acc[mi][ni][gi * 4 + 2];
          v.w += acc[mi][ni][gi * 4 + 3];
          if (outp) *(float4*)(outp + (size_t)row * 1024 + nb + 4 * h + ni * 32 + 8 * gi) = v;
          ov[ni][gi][0] = (h16)v.x; ov[ni][gi][1] = (h16)v.y; ov[ni][gi][2] = (h16)v.z; ov[ni][gi][3] = (h16)v.w;
          sq += v.x * v.x + v.y * v.y + v.z * v.z + v.w * v.w;
        }
      stage_fence();
#pragma unroll
      for (int ni = 0; ni < 2; ni++)
#pragma unroll
        for (int gi = 0; gi < 4; gi++) stage_put(wl, r, h, ni, gi, ov[ni][gi]);
      stage_flush(wl, lane, outh + (size_t)rowb * LD1K + nb, LD1K);
      sq += __shfl_xor(sq, 32);
      if (h == 0) ssq[(size_t)row * 16 + (nb >> 6)] = sq;
    }
    __syncthreads();
  }
}

DI void phase_final(const Params& p, unsigned char* smem) {
  unsigned char* ws = p.ws;
  const h16* A = (const h16*)(ws + OFF_Y2);
  const h16* Bt = (const h16*)(ws + OFF_WOB);
  const h16* __restrict__ res = (const h16*)(ws + OFF_X1H);
  unsigned long long* tags = (unsigned long long*)(ws + OFF_TAGS);
  const int lane = ptid() & 63, w = ptid() >> 6, r = lane & 31, h = lane >> 5, wm = w >> 1, wn = w & 1;
  for (int t = vblock(); t < 128 * 8; t += gridDim.x) {
    const int m0 = (t >> 3) * 256, n0 = (t & 7) * 128;
    f32x16 acc[MI][2];
    gemm_mainloop<true>(A, LD1K, Bt, LD1K, 1024, m0, n0, smem, acc);
    const int nb = n0 + wn * 64;
#pragma unroll
    for (int mi = 0; mi < MI; mi++) {
      const int row = m0 + wm * 128 + mi * 32 + r;
      float sq = 0.f;
      unsigned char* wlr = smem + w * STG_WAVE;
      {
        const h16* rsrc = res + (size_t)(m0 + wm * 128 + mi * 32) * LD1K + nb;
#pragma unroll
        for (int k = 0; k < 4; k++) {
          const int idx = lane + 64 * k, rr = idx >> 3, sg8 = idx & 7;
          *(u32x4*)(wlr + rr * STG_ROW + sg8 * 16) = *(const u32x4*)(rsrc + (size_t)rr * LD1K + sg8 * 8);
        }
        stage_fence();
      }
#pragma unroll
      for (int ni = 0; ni < 2; ni++)
#pragma unroll
        for (int gi = 0; gi < 4; gi++) {
          const h16x4 v = *(const h16x4*)(wlr + r * STG_ROW + (ni * 32 + 8 * gi + 4 * h) * 2);
#pragma unroll
          for (int j = 0; j < 4; j++) acc[mi][ni][gi * 4 + j] += (float)v[j];
#pragma unroll
          for (int j = 0; j < 4; j++) sq += acc[mi][ni][gi * 4 + j] * acc[mi][ni][gi * 4 + j];
        }
      stage_fence();
      sq += __shfl_xor(sq, 32);
      if (h == 0) {
        const unsigned long long pk = (unsigned long long)__float_as_uint(sq) | (1ull << 32);
        __hip_atomic_store(tags + (size_t)row * 16 + (nb >> 6), pk, __ATOMIC_RELAXED, __HIP_MEMORY_SCOPE_AGENT);
      }
    }
#pragma unroll
    for (int mi = 0; mi < MI; mi++) {
      const int row = m0 + wm * 128 + mi * 32 + r;
      float tot = 0.f;
#pragma unroll
      for (int k = 0; k < 8; k++) {
        unsigned long long* tp = tags + (size_t)row * 16 + 8 * h + k;
        unsigned long long v = __hip_atomic_load(tp, __ATOMIC_RELAXED, __HIP_MEMORY_SCOPE_AGENT);
        unsigned spin = 0;
        while ((unsigned)(v >> 32) != 1u && spin < (1u << 22)) {
          __builtin_amdgcn_s_sleep(1);
          v = __hip_atomic_load(tp, __ATOMIC_RELAXED, __HIP_MEMORY_SCOPE_AGENT);
          ++spin;
        }
        tot += __uint_as_float((unsigned)v);
      }
      tot += __shfl_xor(tot, 32);
      const float rinv = rsqrtf(tot * (1.f / 1024.f) + 1e-6f);
      unsigned char* wl = smem + w * STG_WAVE;
#pragma unroll
      for (int ni = 0; ni < 2; ni++)
#pragma unroll
        for (int gi = 0; gi < 4; gi++) {
          const float4 g = *(const float4*)(p.final_norm + nb + 4 * h + ni * 32 + 8 * gi);
          float4 o;
          o.x = acc[mi][ni][gi * 4 + 0] * rinv * g.x;
          o.y = acc[mi][ni][gi * 4 + 1] * rinv * g.y;
          o.z = acc[mi][ni][gi * 4 + 2] * rinv * g.z;
          o.w = acc[mi][ni][gi * 4 + 3] * rinv * g.w;
          *(float4*)(wl + r * 272 + (ni * 32 + 8 * gi + 4 * h) * 4) = o;
        }
      stage_fence();
      const int rowb = m0 + wm * 128 + mi * 32;
#pragma unroll
      for (int k = 0; k < 8; k++) {
        const int idx = lane + 64 * k, rr = idx >> 4, sg4 = idx & 15;
        *(float4*)(p.out + (size_t)(rowb + rr) * 1024 + nb + sg4 * 4) = *(const float4*)(wl + rr * 272 + sg4 * 16);
      }
      stage_fence();
    }
    __syncthreads();
  }
}

DI void phase4(const Params& p, unsigned char* smem) {
  unsigned char* ws = p.ws;
  const h16* A = (const h16*)(ws + OFF_X1H);
  const h16* Bt = (const h16*)(ws + OFF_W4T);
  const float* ssq = (const float*)(ws + OFF_SSQX1);
  h16* ckv = (h16*)(ws + OFF_CKV);
  h16* cq = (h16*)(ws + OFF_CQ);
  h16* sg2 = (h16*)(ws + OFF_SG2);
  h16* Kf = (h16*)(ws + OFF_KF);
  float* ssqkv = (float*)(ws + OFF_SSQKV);
  float* ssqq = (float*)(ws + OFF_SSQQ);
  const float* ct = (const float*)(ws + OFF_COS);
  const float* st = (const float*)(ws + OFF_SIN);
  float* rinv_s = (float*)(smem + GEMM_LDS);
  const int tid = ptid(), lane = tid & 63, w = tid >> 6, r = lane & 31, h = lane >> 5, wm = w >> 1, wn = w & 1;
  for (int base = 0; base < 128 * 14; base += gridDim.x) {
    const int t = base + ((base + (int)gridDim.x <= 128 * 14) ? vblock() : (int)blockIdx.x);
    if (t >= 128 * 14) break;
    const int m0 = (t / 14) * 256, n0 = (t % 14) * 128;
    {
      const float4* sp = (const float4*)(ssq + (size_t)(m0 + tid) * 16);
      float s = 0.f;
#pragma unroll
      for (int i = 0; i < 4; i++) { const float4 v = sp[i]; s += v.x + v.y + v.z + v.w; }
      rinv_s[tid] = rsqrtf(s * (1.f / 1024.f) + 1e-6f);
    }
    f32x16 acc[MI][2];
    gemm_mainloop<true>(A, LD1K, Bt, LD1K, 1024, m0, n0, smem, acc);
    const int nb = n0 + wn * 64;
    const int sub = nb >> 6;
    const int lr0 = wm * 128 + r;
    const int row0 = m0 + lr0;
    unsigned char* wl = smem + w * STG_WAVE;
    const int rowt = m0 + wm * 128;
    if (sub < 10) {
      const bool iskv = sub < 4;
      h16* gb = iskv ? ckv + (size_t)rowt * LDKV + nb : cq + (size_t)rowt * 384 + (nb - 256);
      const int ld = iskv ? LDKV : 384;
      float* sqb = iskv ? ssqkv + (size_t)row0 * 4 + sub : ssqq + (size_t)row0 * 8 + (sub - 4);
      const int sld = iskv ? 4 : 8;
#pragma unroll
      for (int mi = 0; mi < MI; mi++) {
        const float ri = rinv_s[lr0 + mi * 32];
        float sq = 0.f;
#pragma unroll
        for (int ni = 0; ni < 2; ni++)
#pragma unroll
          for (int gi = 0; gi < 4; gi++) {
            h16x4 o;
#pragma unroll
            for (int j = 0; j < 4; j++) {
              const float v = acc[mi][ni][gi * 4 + j] * ri;
              o[j] = (h16)v;
              sq += v * v;
            }
            stage_put(wl, r, h, ni, gi, o);
          }
        stage_flush(wl, lane, gb + (size_t)mi * 32 * ld, ld);
        sq += __shfl_xor(sq, 32);
        if (h == 0) sqb[mi * 32 * sld] = sq;
      }
    } else if (sub < 26) {
      h16* gb = sg2 + (size_t)rowt * 1024 + (nb - 640);
#pragma unroll
      for (int mi = 0; mi < MI; mi++) {
        const float ri = rinv_s[lr0 + mi * 32];
#pragma unroll
        for (int ni = 0; ni < 2; ni++)
#pragma unroll
          for (int gi = 0; gi < 4; gi++) {
            h16x4 o;
#pragma unroll
            for (int j = 0; j < 4; j++) o[j] = (h16)silu_f(acc[mi][ni][gi * 4 + j] * ri);
            stage_put(wl, r, h, ni, gi, o);
          }
        stage_flush(wl, lane, gb + (size_t)mi * 32 * 1024, 1024);
      }
    } else if (sub == 26) {
      const int b = m0 >> 11, s0 = (m0 & 2047) + lr0;
#pragma unroll
      for (int mi = 0; mi < MI; mi++) {
        const float ri = rinv_s[lr0 + mi * 32];
        const int s = s0 + mi * 32;
#pragma unroll
        for (int gi = 0; gi < 4; gi++) {
          const int j0 = 8 * gi + 4 * h;
          const float4 c = *(const float4*)(ct + s * 32 + j0);
          const float4 sn = *(const float4*)(st + s * 32 + j0);
          const float cc[4] = {c.x, c.y, c.z, c.w}, ss[4] = {sn.x, sn.y, sn.z, sn.w};
          h16x4 o1, o2;
#pragma unroll
          for (int j = 0; j < 4; j++) {
            const float x1 = acc[mi][0][gi * 4 + j] * ri, x2 = acc[mi][1][gi * 4 + j] * ri;
            o1[j] = (h16)(x1 * cc[j] - x2 * ss[j]);
            o2[j] = (h16)(x2 * cc[j] + x1 * ss[j]);
          }
          stage_put(wl, r, h, 0, gi, o1);
          stage_put(wl, r, h, 1, gi, o2);
        }
        stage_fence();
        u32x4 vv[4];
#pragma unroll
        for (int k = 0; k < 4; k++) {
          const int idx = lane + 64 * k;
          vv[k] = *(const u32x4*)(wl + (idx >> 3) * STG_ROW + (idx & 7) * 16);
        }
        const int st0 = (m0 & 2047) + wm * 128 + mi * 32;
#pragma unroll 1
        for (int hd = 0; hd < 8; hd++) {
          h16* kp = Kf + ((size_t)(b * 8 + hd) * SEQ + st0) * 192 + 128;
#pragma unroll
          for (int k = 0; k < 4; k++) {
            const int idx = lane + 64 * k;
            *(u32x4*)(kp + (size_t)(idx >> 3) * 192 + (idx & 7) * 8) = vv[k];
          }
        }
        stage_fence();
      }
    }
    __syncthreads();
  }
}

template <bool ISQ>
DI void phase5_part(const Params& p, unsigned char* smem) {
  unsigned char* ws = p.ws;
  const h16* ckv = (const h16*)(ws + OFF_CKV);
  const h16* cq = (const h16*)(ws + OFF_CQ);
  const h16* Wkv = (const h16*)(ws + OFF_W5KV);
  const h16* Wq = (const h16*)(ws + OFF_W5Q);
  const float* ssqkv = (const float*)(ws + OFF_SSQKV);
  const float* ssqq = (const float*)(ws + OFF_SSQQ);
  h16* Kf = (h16*)(ws + OFF_KF);
  h16* Vt = (h16*)(ws + OFF_VT);
  h16* Q = (h16*)(ws + OFF_Q);
  const float* ct = (const float*)(ws + OFF_COS);
  const float* st = (const float*)(ws + OFF_SIN);
  float* rinv_s = (float*)(smem + GEMM_LDS);
  const int tid = ptid(), lane = tid & 63, w = tid >> 6, r = lane & 31, h = lane >> 5, wm = w >> 1, wn = w & 1;
  const float qscale = 0.07216878364870322f * 1.4426950408889634f;
  constexpr int NTT = ISQ ? 12 : 16;
  for (int t = vblock(); t < 128 * NTT; t += gridDim.x) {
    const int mt = t / NTT, nt = (t % NTT) + (ISQ ? 16 : 0);
    const int m0 = mt * 256;
    const int bb = m0 >> 11;
    const int lr0 = wm * 128 + 4 * h;
    const int s0 = (m0 & 2047) + lr0;
    f32x16 acc[MI][2];
    constexpr bool is_q = ISQ;
    const bool is_v = (nt >= 8) && !is_q;
    {
      float rv;
      if (!is_q) {
        const float4 v = *(const float4*)(ssqkv + (size_t)(m0 + tid) * 4);
        rv = rsqrtf((v.x + v.y + v.z + v.w) * (1.f / 256.f) + 1e-6f);
      } else {
        const float4* sp = (const float4*)(ssqq + (size_t)(m0 + tid) * 8);
        const float4 v0 = sp[0], v1 = sp[1];
        rv = rsqrtf((v0.x + v0.y + v0.z + v0.w + v1.x + v1.y) * (1.f / 384.f) + 1e-6f) * qscale;
      }
      rinv_s[tid] = rv;
    }
    const h16* Ap = is_q ? cq : ckv;
    const h16* Bp = is_q ? Wq : Wkv;
    constexpr int Kd = is_q ? 384 : 256;
    constexpr int ldk = is_q ? 384 : LDKV;
    const int n0 = is_q ? (nt - 16) * 128 : nt * 128;
    gemm_mainloop<true, false>(Ap, ldk, Bp, ldk, Kd, m0, n0, smem, acc);
    const int lrw = wm * 128 + r;
    const int sw = (m0 & 2047) + lrw;
    unsigned char* wl = smem + w * STG_WAVE;
    const int st0 = (m0 & 2047) + wm * 128;
    if (!is_v) {
      const int sub = (n0 >> 6) + wn;
      const int hd = is_q ? sub / 3 : nt;
      const int part = is_q ? sub % 3 : wn;
      h16* gb = (is_q ? Q : Kf) + ((size_t)(bb * 8 + hd) * SEQ + st0) * 192 + part * 64;
      if (!is_q || part < 2) {
#pragma unroll
        for (int mi = 0; mi < MI; mi++) {
          const float ri = rinv_s[lrw + mi * 32];
#pragma unroll
          for (int ni = 0; ni < 2; ni++)
#pragma unroll
            for (int gi = 0; gi < 4; gi++) {
              h16x4 o;
#pragma unroll
              for (int j = 0; j < 4; j++) o[j] = (h16)(acc[mi][ni][gi * 4 + j] * ri);
              stage_put(wl, r, h, ni, gi, o);
            }
          stage_flush(wl, lane, gb + (size_t)mi * 32 * 192, 192);
        }
      } else {
#pragma unroll
        for (int mi = 0; mi < MI; mi++) {
          const float ri = rinv_s[lrw + mi * 32];
          const int s = sw + mi * 32;
#pragma unroll
          for (int gi = 0; gi < 4; gi++) {
            const int j0 = 8 * gi + 4 * h;
            const float4 c = *(const float4*)(ct + s * 32 + j0);
            const float4 sn = *(const float4*)(st + s * 32 + j0);
            const float cc[4] = {c.x, c.y, c.z, c.w}, ss[4] = {sn.x, sn.y, sn.z, sn.w};
            h16x4 o1, o2;
#pragma unroll
            for (int j = 0; j < 4; j++) {
              const float x1 = acc[mi][0][gi * 4 + j] * ri, x2 = acc[mi][1][gi * 4 + j] * ri;
              o1[j] = (h16)(x1 * cc[j] - x2 * ss[j]);
              o2[j] = (h16)(x2 * cc[j] + x1 * ss[j]);
            }
            stage_put(wl, r, h, 0, gi, o1);
            stage_put(wl, r, h, 1, gi, o2);
          }
          stage_flush(wl, lane, gb + (size_t)mi * 32 * 192, 192);
        }
      }
    } else {
#pragma unroll
      for (int mp = 0; mp < 2; mp++) {
#pragma unroll
        for (int m2 = 0; m2 < 2; m2++) {
          const int mi = mp * 2 + m2;
          const float ri = rinv_s[lrw + mi * 32];
          const int t = m2 * 32 + r;
          const int pos = (t & ~15) + 8 * ((t >> 2) & 1) + 4 * ((t >> 3) & 1) + (t & 3);
#pragma unroll
          for (int ni = 0; ni < 2; ni++)
#pragma unroll
            for (int i = 0; i < 16; i++)
              *(h16*)(wl + (ni * 32 + crow(i, h)) * STG_ROW + pos * 2) = (h16)(acc[mi][ni][i] * ri);
        }
        stage_fence();
        const int kt = (st0 + mp * 64) >> 6;
        h16* gv = Vt + (((size_t)(bb * 8 + (nt - 8)) * 32 + kt) * 128 + wn * 64) * 64;
#pragma unroll
        for (int k = 0; k < 8; k++) {
          const int idx = lane + 64 * k, row = idx >> 3, seg = idx & 7;
          *(u32x4*)(gv + row * 64 + seg * 8) = *(const u32x4*)(wl + row * STG_ROW + seg * 16);
        }
        stage_fence();
      }
    }
    __syncthreads();
  }
}

DI void phase5(const Params& p, unsigned char* smem) {
  phase5_part<false>(p, smem);
  phase5_part<true>(p, smem);
}

constexpr int KROW = 400;
constexpr int VROW = 144;
DI void phase6(const Params& p, unsigned char* smem) {
  unsigned char* ws = p.ws;
  const h16* Q = (const h16*)(ws + OFF_Q);
  const h16* Kf = (const h16*)(ws + OFF_KF);
  const h16* Vt = (const h16*)(ws + OFF_VT);
  const h16* sg2 = (const h16*)(ws + OFF_SG2);
  h16* y2 = (h16*)(ws + OFF_Y2);
  unsigned char* Ks = smem;
  unsigned char* Vs = smem + 64 * KROW;
  const int tid = ptid(), lane = tid & 63, w = tid >> 6, r = lane & 31, h = lane >> 5;
  for (int it2 = vblock() * 2; it2 < 2048; it2 += gridDim.x * 2)
  for (int sel = 0; sel < 2; sel++) {
    const int bh = it2 >> 4, xx = (it2 >> 1) & 7;
    const int qb = sel ? xx : 15 - xx;
    const int b = bh >> 3, hd = bh & 7;
    const int qrow = qb * 128 + w * 32 + r;
    h16x8 qf[12];
    {
      const h16* qp = Q + ((size_t)bh * SEQ + qrow) * 192 + h * 8;
#pragma unroll
      for (int ks = 0; ks < 12; ks++) qf[ks] = *(const h16x8*)(qp + ks * 16);
    }
    f32x16 O[4];
#pragma unroll
    for (int dt = 0; dt < 4; dt++)
#pragma unroll
      for (int i = 0; i < 16; i++) O[dt][i] = 0.f;
    float m = -INFINITY, l = 0.f;
    const int nkt = 2 * qb + 2;
    const h16* kbase = Kf + (size_t)bh * SEQ * 192;
    const h16* vbase = Vt + (size_t)bh * 128 * SEQ;
    u32x4 kst[6], vst[4];
    const h16* kg = kbase + (size_t)(tid >> 3) * 192 + (tid & 7) * 8;
    const h16* vg = vbase + (size_t)(tid >> 3) * 64 + (tid & 7) * 8;
    unsigned char* kw = Ks + (tid >> 3) * KROW + (tid & 7) * 16;
    unsigned char* vw = Vs + (tid >> 3) * VROW + (tid & 7) * 16;
#pragma unroll
    for (int i = 0; i < 6; i++) kst[i] = *(const u32x4*)(kg + (i & 1) * 32 * 192 + (i >> 1) * 64);
#pragma unroll
    for (int i = 0; i < 4; i++) vst[i] = *(const u32x4*)(vg + (size_t)i * 32 * 64);
    for (int kt = 0; kt < nkt; kt++) {
#pragma unroll
      for (int i = 0; i < 6; i++) *(u32x4*)(kw + (i & 1) * 32 * KROW + (i >> 1) * 128) = kst[i];
#pragma unroll
      for (int i = 0; i < 4; i++) *(u32x4*)(vw + i * 32 * VROW) = vst[i];
      __syncthreads();
      if (kt + 1 < nkt) {
        kg += 64 * 192;
        vg += 8192;
#pragma unroll
        for (int i = 0; i < 6; i++) kst[i] = *(const u32x4*)(kg + (i & 1) * 32 * 192 + (i >> 1) * 64);
#pragma unroll
        for (int i = 0; i < 4; i++) vst[i] = *(const u32x4*)(vg + (size_t)i * 32 * 64);
      }
#pragma unroll
      for (int half = 0; half < 2; half++) {
        const int sb = (kt - (nkt - 2)) * 2 + half;
        if (sb > w) continue;
        f32x16 sc;
#pragma unroll
        for (int i = 0; i < 16; i++) sc[i] = 0.f;
        const unsigned char* kr = Ks + (half * 32 + r) * KROW + h * 16;
#pragma unroll
        for (int g = 0; g < 3; g++) {
          h16x8 kf[4];
#pragma unroll
          for (int j = 0; j < 4; j++) kf[j] = *(const h16x8*)(kr + (g * 4 + j) * 32);
#pragma unroll
          for (int j = 0; j < 4; j++) sc = MFMA(kf[j], qf[g * 4 + j], sc);
        }
        if (sb == w) {
#pragma unroll
          for (int i = 0; i < 16; i++)
            if (crow(i, h) > r) sc[i] = -INFINITY;
        }
        float mx = sc[0];
#pragma unroll
        for (int i = 1; i < 16; i++) mx = fmaxf(mx, sc[i]);
        mx = fmaxf(mx, __shfl_xor(mx, 32));
        const float mn = fmaxf(m, mx);
        if (__builtin_amdgcn_ballot_w64(mn > m) != 0ull) {
          const float alpha = fexp2(m - mn);
          m = mn;
          l *= alpha;
#pragma unroll
          for (int dt = 0; dt < 4; dt++)
#pragma unroll
            for (int i = 0; i < 16; i++) O[dt][i] *= alpha;
        }
        float ls = 0.f;
#pragma unroll
        for (int i = 0; i < 16; i++) {
          sc[i] = fexp2(sc[i] - m);
          ls += sc[i];
        }
        l += ls;
        h16x8 pf0, pf1;
#pragma unroll
        for (int jj = 0; jj < 8; jj++) {
          pf0[jj] = (h16)sc[jj];
          pf1[jj] = (h16)sc[8 + jj];
        }
        const unsigned char* vr = Vs + r * VROW + h * 16 + half * 64;
#pragma unroll
        for (int dp = 0; dp < 2; dp++) {
          h16x8 vf[4];
#pragma unroll
          for (int j = 0; j < 4; j++) vf[j] = *(const h16x8*)(vr + (dp * 2 + (j >> 1)) * 32 * VROW + (j & 1) * 32);
#pragma unroll
          for (int j = 0; j < 4; j++) O[dp * 2 + (j >> 1)] = MFMA(vf[j], (j & 1) ? pf1 : pf0, O[dp * 2 + (j >> 1)]);
        }
      }
      __syncthreads();
    }
    l += __shfl_xor(l, 32);
    const float inv = 1.f / l;
    {
      unsigned char* wl = smem + w * STG_WAVE;
      const int rowb = b * SEQ + qb * 128 + w * 32;
#pragma unroll
      for (int dp = 0; dp < 2; dp++) {
        const h16* gsrc = sg2 + (size_t)rowb * 1024 + hd * 128 + dp * 64;
#pragma unroll
        for (int k = 0; k < 4; k++) {
          const int idx = lane + 64 * k, rr = idx >> 3, sg8 = idx & 7;
          *(u32x4*)(wl + rr * STG_ROW + sg8 * 16) = *(const u32x4*)(gsrc + (size_t)rr * 1024 + sg8 * 8);
        }
        stage_fence();
        h16x4 ov[2][4];
#pragma unroll
        for (int ni = 0; ni < 2; ni++)
#pragma unroll
          for (int gi = 0; gi < 4; gi++) {
            const h16x4 gt = *(const h16x4*)(wl + r * STG_ROW + (ni * 32 + 8 * gi + 4 * h) * 2);
#pragma unroll
            for (int jj = 0; jj < 4; jj++) ov[ni][gi][jj] = (h16)(O[dp * 2 + ni][gi * 4 + jj] * inv * (float)gt[jj]);
          }
        stage_fence();
#pragma unroll
        for (int ni = 0; ni < 2; ni++)
#pragma unroll
          for (int gi = 0; gi < 4; gi++) stage_put(wl, r, h, ni, gi, ov[ni][gi]);
        stage_flush(wl, lane, y2 + (size_t)rowb * LD1K + hd * 128 + dp * 64, LD1K);
      }
    }
    __syncthreads();
  }
}

DI void phase8(const Params& p) {
  const float* ssq = (const float*)(p.ws + OFF_SSQO);
  const int tid = ptid(), lane = tid & 63;
  const int nw = gridDim.x * 4;
  for (int row = blockIdx.x * 4 + (tid >> 6); row < M_TOK; row += nw) {
    const float4* sp = (const float4*)(ssq + (size_t)row * 16);
    float s = 0.f;
#pragma unroll
    for (int i = 0; i < 4; i++) { const float4 v = sp[i]; s += v.x + v.y + v.z + v.w; }
    const float rinv = rsqrtf(s * (1.f / 1024.f) + 1e-6f);
    const float4* xr = (const float4*)((const float*)(p.ws + OFF_X2) + (size_t)row * 1024);
    float4* orow = (float4*)(p.out + (size_t)row * 1024);
#pragma unroll
    for (int i = 0; i < 4; i++) {
      float4 v = xr[lane + 64 * i];
      const float4 g = ((const float4*)p.final_norm)[lane + 64 * i];
      v.x *= rinv * g.x; v.y *= rinv * g.y; v.z *= rinv * g.z; v.w *= rinv * g.w;
      orow[lane + 64 * i] = v;
    }
  }
}

#define XB_TMO      128
#define XB_XCNT(j)  (256  + 64 * (j))
#define XB_XSUB(j)  (1280 + 64 * (j))
#define XB_XGEN(j)  (2304 + 64 * (j))
#define XB_TOP      3328
#define XB_TOPGEN   3392
#define XCD_BAR_WORDS 3456
#define XB_SPIN_CAP (1u << 18)
#define LAS __attribute__((address_space(3)))
DI unsigned xb_ld(unsigned* p) { return __hip_atomic_load(p, __ATOMIC_RELAXED, __HIP_MEMORY_SCOPE_AGENT); }
DI unsigned xb_add(unsigned* p, unsigned v) { return __hip_atomic_fetch_add(p, v, __ATOMIC_RELAXED, __HIP_MEMORY_SCOPE_AGENT); }
DI unsigned xb_xcc_id() { return (unsigned)__builtin_amdgcn_s_getreg((3 << 11) | 20) & 0xFu; }
#define XB_SPIN(cond, bar) do { unsigned _sp = 0; while (cond) { __builtin_amdgcn_s_sleep(1); \
    if ((++_sp & 255u) == 0u) { if (xb_ld(&(bar)[XB_TMO])) break; if (_sp > XB_SPIN_CAP) { atomicAdd(&(bar)[XB_TMO], 1u); break; } } } } while (0)
struct XcdBarrier { unsigned* bar; unsigned x; volatile LAS unsigned* st; };
DI XcdBarrier xcd_barrier_post(unsigned* bar, volatile LAS unsigned* st) {
  XcdBarrier b; b.bar = bar; b.x = xb_xcc_id(); b.st = st;
  if (threadIdx.x == 0) (void)xb_add(&bar[XB_XCNT(b.x)], 1u);
  return b;
}
DI void xcd_barrier_complete(unsigned* bar, unsigned x, unsigned& nloc, unsigned& nx) {
  const unsigned G = gridDim.x;
  unsigned sum, cnt, mine, sp = 0u;
  for (;;) {
    sum = 0u; cnt = 0u; mine = 0u;
#pragma unroll
    for (unsigned j = 0; j < 16; ++j) { const unsigned c = xb_ld(&bar[XB_XCNT(j)]); sum += c; cnt += (c > 0u) ? 1u : 0u; mine = (j == x) ? c : mine; }
    if (sum == G) break;
    __builtin_amdgcn_s_sleep(1);
    if ((++sp & 255u) == 0u) { if (xb_ld(&bar[XB_TMO])) break; if (sp > XB_SPIN_CAP) { atomicAdd(&bar[XB_TMO], 1u); break; } }
  }
  nloc = mine > 0u ? mine : 1u; nx = cnt > 0u ? cnt : 1u;
}
DI void xcd_barrier(const XcdBarrier& b) {
  asm volatile("s_waitcnt vmcnt(0)" ::: "memory");
  __syncthreads();
  if (threadIdx.x == 0) {
    unsigned* bar = b.bar;
    __builtin_amdgcn_s_waitcnt(0);
    unsigned nloc = b.st[0], nx = b.st[1];
    if (nloc == 0u) { xcd_barrier_complete(bar, b.x, nloc, nx); b.st[0] = nloc; b.st[1] = nx; }
    const unsigned old = xb_add(&bar[XB_XSUB(b.x)], 1u);
    const unsigned gen = old / nloc;
    if (old + 1u == (gen + 1u) * nloc) {
      __builtin_amdgcn_fence(__ATOMIC_RELEASE, "agent");
      asm volatile("s_waitcnt vmcnt(0)" ::: "memory");
      const unsigned og = xb_add(&bar[XB_TOP], 1u);
      const unsigned tg = og / nx;
      if (og + 1u == (tg + 1u) * nx) xb_add(&bar[XB_TOPGEN], 1u);
      else XB_SPIN(xb_ld(&bar[XB_TOPGEN]) == tg, bar);
      __builtin_amdgcn_fence(__ATOMIC_ACQUIRE, "agent");
      xb_add(&bar[XB_XGEN(b.x)], 1u);
      asm volatile("s_waitcnt vmcnt(0)" ::: "memory");
    } else {
      XB_SPIN(xb_ld(&bar[XB_XGEN(b.x)]) == gen, bar);
      __builtin_amdgcn_fence(__ATOMIC_ACQUIRE, "agent");
      asm volatile("s_waitcnt vmcnt(0)" ::: "memory");
    }
  }
  __syncthreads();
}

constexpr int SMEM_BYTES = 56320;
__global__ void __launch_bounds__(256, 2) yoco_fwd(Params p) {
  __shared__ __attribute__((aligned(16))) unsigned char smem[SMEM_BYTES];
  __shared__ uint4 xb_words;
  unsigned char* ws = p.ws;
  if (threadIdx.x == 0) xb_words = make_uint4(0u, 0u, 0u, 0u);
  __syncthreads();
  const XcdBarrier xb = xcd_barrier_post((unsigned*)(ws + OFF_BAR), (volatile LAS unsigned*)&xb_words);
  if (p.out == nullptr) {
    const unsigned long long mg = *(const volatile unsigned long long*)((const char*)__builtin_amdgcn_implicitarg_ptr() + 88);
    if (mg == 1ull) ((volatile unsigned*)(ws + OFF_BAR))[XB_TMO] = 1u;
  }
#ifndef DUP
#define DUP 0
#endif
#ifndef PHM
#define PHM 0xfff
#endif
#define RUNP(bit, call) { if (PHM & bit) { call; } xcd_barrier(xb); if (DUP & bit) { call; xcd_barrier(xb); } }
  RUNP(1, phase0(p, smem))
  RUNP(2, phase1(p, smem))
  RUNP(4, phase2(p, smem))
  RUNP(8, phase_res_gemm((const h16*)(ws + OFF_Y), LDY, 1280, (const h16*)(ws + OFF_WOA), p.x, nullptr, (h16*)(ws + OFF_X1H), (float*)(ws + OFF_SSQX1), smem))
  RUNP(16, phase4(p, smem))
  RUNP(32, phase5(p, smem))
  RUNP(64, phase6(p, smem))
  if (PHM & 128) phase_final(p, smem);
}

extern "C" void kernel_launch(void* const* d_in, const int* in_sizes, int n_in, void* d_out, int out_size, void* d_ws,
                              size_t ws_size, hipStream_t stream) {
  static int grid_blocks = 0;
  static int cus_s = 0;
  if (!grid_blocks) {
    int dev = 0, cus = 0;
    (void)hipGetDevice(&dev);
    (void)hipDeviceGetAttribute(&cus, hipDeviceAttributeMultiprocessorCount, dev);
    if (cus < 8) cus = 256;
    cus -= cus % 8;
    cus_s = cus;
    grid_blocks = cus * 2;
  }
  Params p{};
  const float** pp = (const float**)&p;
  for (int i = 0; i < 22; i++) pp[i] = (const float*)d_in[i];
  p.out = (float*)d_out;
  p.ws = (unsigned char*)d_ws;
  (void)hipMemsetAsync((unsigned char*)d_ws + OFF_BAR, 0, XCD_BAR_WORDS * sizeof(unsigned), stream);
  void* args[] = {&p};
  hipError_t e = hipLaunchCooperativeKernel((void*)yoco_fwd, dim3(grid_blocks), dim3(256), args, 0, stream);
  if (e != hipSuccess && grid_blocks != cus_s) {
    (void)hipGetLastError();
    grid_blocks = cus_s;
    e = hipLaunchCooperativeKernel((void*)yoco_fwd, dim3(grid_blocks), dim3(256), args, 0, stream);
  }
  if (e != hipSuccess) fprintf(stderr, "cooperative launch failed: %s (grid %d)\n", hipGetErrorString(e), grid_blocks);
}
```

```cpp
#include <hip/hip_runtime.h>
#include <hip/hip_cooperative_groups.h>
#include <cstdio>
namespace cg = cooperative_groups;

typedef _Float16 h16;
typedef __attribute__((ext_vector_type(8))) _Float16 h16x8;
typedef __attribute__((ext_vector_type(4))) _Float16 h16x4;
typedef __attribute__((ext_vector_type(16))) float f32x16;
typedef __attribute__((ext_vector_type(4))) unsigned u32x4;

#define DI __device__ __forceinline__
#define MFMA(a, b, c) __builtin_amdgcn_mfma_f32_32x32x16_f16((a), (b), (c), 0, 0, 0)

constexpr int M_TOK = 32768;
constexpr int SEQ = 2048;
constexpr size_t MiB = 1u << 20;
constexpr int LD1K = 1088;
constexpr int LDY = 1344;
constexpr int LDKV = 320;
constexpr size_t OFF_W1T = 0;
constexpr size_t OFF_WRG = 5 * MiB + 512 * 1024;
constexpr size_t OFF_WIG = 6 * MiB;
constexpr size_t OFF_WOA = 6 * MiB + 512 * 1024;
constexpr size_t OFF_W4T = 9 * MiB + 512 * 1024;
constexpr size_t OFF_W5KV = 13 * MiB + 512 * 1024;
constexpr size_t OFF_W5Q = 15 * MiB;
constexpr size_t OFF_WOB = 16 * MiB + 512 * 1024;
constexpr size_t OFF_COS = 19 * MiB;
constexpr size_t OFF_SIN = OFF_COS + 256 * 1024;
constexpr size_t OFF_SSQX1 = 19 * MiB + 512 * 1024;
constexpr size_t OFF_SSQKV = 21 * MiB + 512 * 1024;
constexpr size_t OFF_SSQQ = 22 * MiB;
constexpr size_t OFF_SSQO = 23 * MiB;
constexpr size_t OFF_BAR = 25 * MiB;
constexpr size_t SLOT1 = 26 * MiB;
constexpr size_t SLOT2 = 110 * MiB;
constexpr size_t SLOT3 = 270 * MiB;
constexpr size_t OFF_H0 = SLOT1, OFF_Y = SLOT1, OFF_CKV = SLOT1, OFF_CQ = SLOT1 + 24 * MiB, OFF_Y2 = SLOT1;
constexpr size_t OFF_XB = SLOT2, OFF_SG = SLOT2 + 80 * MiB, OFF_X1H = 436 * MiB  , OFF_Q = SLOT2, OFF_SG2 = SLOT2 + 96 * MiB;
constexpr size_t OFF_X2 = SLOT2;
constexpr size_t OFF_TAGS = 432 * MiB;
constexpr size_t OFF_KF = SLOT3, OFF_VT = SLOT3 + 96 * MiB;

struct Params {
  const float *x, *norm_a, *w_in_a, *conv_w, *conv_b, *w_rg, *b_rg, *w_ig, *b_ig, *lam, *w_out_a;
  const float *norm_kv, *w_dkv, *kv_norm, *w_uk, *w_uv, *norm_b, *w_in_b, *q_norm, *w_uq, *w_out_b, *final_norm;
  float* out;
  unsigned char* ws;
};

DI int crow(int i, int h) { return (i & 3) + 8 * (i >> 2) + 4 * h; }
DI constexpr int crow0(int i) { return (i & 3) + 8 * (i >> 2); }
DI float fexp2(float x) { return __builtin_amdgcn_exp2f(x); }
DI float frcp(float x) { return __builtin_amdgcn_rcpf(x); }
DI float silu_f(float v) { return v * frcp(1.f + fexp2(-1.44269504f * v)); }
DI float wave_sum(float v) {
#pragma unroll
  for (int o = 32; o; o >>= 1) v += __shfl_xor(v, o);
  return v;
}
DI float half_sum32(float v) {
#pragma unroll
  for (int o = 16; o; o >>= 1) v += __shfl_xor(v, o);
  return v;
}
DI int ptid() { int t = __builtin_amdgcn_workitem_id_x(); asm volatile("" : "+v"(t)); return t; }
DI int vblock() { return (blockIdx.x & 7) * (gridDim.x >> 3) + (blockIdx.x >> 3); }
DI int round_item(int k, int n) {
  const int G = gridDim.x, base = k * G;
  if (base + G <= n) return base + vblock();
  const int t = base + (int)blockIdx.x;
  return t < n ? t : -1;
}

DI void transpose_tile(const float* __restrict__ src, int ld, int n_off, h16* __restrict__ dst, int dst_ld, int row_off,
                       const float* __restrict__ gain, int tn, int tk, float* lds) {
  const int tid = ptid();
  const int k0 = tk * 64, n0 = tn * 64;
#pragma unroll
  for (int i = 0; i < 4; i++) {
    const int idx = tid + 256 * i, kk = idx >> 4, n4 = idx & 15;
    const float4 v = *(const float4*)(src + (size_t)(k0 + kk) * ld + n_off + n0 + n4 * 4);
    const float g = gain ? gain[k0 + kk] : 1.f;
    float* d = lds + kk * 65 + n4 * 4;
    d[0] = v.x * g; d[1] = v.y * g; d[2] = v.z * g; d[3] = v.w * g;
  }
  __syncthreads();
#pragma unroll
  for (int i = 0; i < 2; i++) {
    const int idx = tid + 256 * i, nn = idx >> 3, kc = idx & 7;
    h16x8 o;
#pragma unroll
    for (int j = 0; j < 8; j++) o[j] = (h16)lds[(kc * 8 + j) * 65 + nn];
    *(h16x8*)(dst + (size_t)(row_off + n0 + nn) * dst_ld + k0 + kc * 8) = o;
  }
  __syncthreads();
}

DI void convert_tile(const Params& p, int t, float* lds) {
  unsigned char* ws = p.ws;
    int u = t;
    if (u < 640) { transpose_tile(p.w_in_a, 2560, 0, (h16*)(ws + OFF_W1T), LD1K, 0, nullptr, u % 40, u / 40, lds); return; }
    u -= 640;
    if (u < 80) {
      const int which = u / 40, n = (u % 40) >> 2, tn = u & 1, tk = (u >> 1) & 1;
      transpose_tile((which ? p.w_ig : p.w_rg) + n * 16384, 128, 0, (h16*)(ws + (which ? OFF_WIG : OFF_WRG)), 128, n * 128, nullptr, tn, tk, lds);
      return;
    }
    u -= 80;
    if (u < 320) { transpose_tile(p.w_out_a, 1024, 0, (h16*)(ws + OFF_WOA), LDY, 0, nullptr, u % 16, u / 16, lds); return; }
    u -= 320;
    if (u < 64) { transpose_tile(p.w_dkv, 320, 0, (h16*)(ws + OFF_W4T), LD1K, 0, p.norm_kv, u % 4, u / 4, lds); return; }
    u -= 64;
    if (u < 96) { transpose_tile(p.w_in_b, 1408, 0, (h16*)(ws + OFF_W4T), LD1K, 256, p.norm_b, u % 6, u / 6, lds); return; }
    u -= 96;
    if (u < 256) { transpose_tile(p.w_in_b, 1408, 384, (h16*)(ws + OFF_W4T), LD1K, 640, p.norm_b, u % 16, u / 16, lds); return; }
    u -= 256;
    if (u < 16) { transpose_tile(p.w_dkv, 320, 256, (h16*)(ws + OFF_W4T), LD1K, 1664, p.norm_kv, 0, u, lds); return; }
    u -= 16;
    if (u < 64) { transpose_tile(p.w_uk, 1024, 0, (h16*)(ws + OFF_W5KV), LDKV, 0, p.kv_norm, u % 16, u / 16, lds); return; }
    u -= 64;
    if (u < 64) { transpose_tile(p.w_uv, 1024, 0, (h16*)(ws + OFF_W5KV), LDKV, 1024, p.kv_norm, u % 16, u / 16, lds); return; }
    u -= 64;
    if (u < 144) { transpose_tile(p.w_uq, 1536, 0, (h16*)(ws + OFF_W5Q), 384, 0, p.q_norm, u % 24, u / 24, lds); return; }
    u -= 144;
    transpose_tile(p.w_out_b, 1024, 0, (h16*)(ws + OFF_WOB), LD1K, 0, nullptr, u % 16, u / 16, lds);
}

DI void phase0(const Params& p, unsigned char* smem) {
  float* lds = (float*)smem;
  unsigned char* ws = p.ws;
  const int tid = ptid(), lane = tid & 63;
  for (int t = blockIdx.x; t < 720; t += gridDim.x) convert_tile(p, t, lds);
  {
    u32x4* tz = (u32x4*)(ws + OFF_TAGS);
    for (int e = blockIdx.x * 256 + tid; e < M_TOK * 16 * 8 / 16; e += gridDim.x * 256) tz[e] = (u32x4){0u, 0u, 0u, 0u};
  }
  {
    h16* z = (h16*)(ws + OFF_W4T) + (size_t)1728 * LD1K;
    for (int e = blockIdx.x * 256 + tid; e < 64 * LD1K; e += gridDim.x * 256) z[e] = (h16)0.f;
  }
  {
    float* ct = (float*)(ws + OFF_COS);
    float* st = (float*)(ws + OFF_SIN);
    for (int e = blockIdx.x * 256 + tid; e < SEQ * 32; e += gridDim.x * 256) {
      const int pos = e >> 5, i = e & 31;
      const float inv = powf(10000.f, -(float)(2 * i) / 64.f);
      const float ang = (float)pos * inv;
      const double a = (double)ang;
      const double k = rint(a * 0.15915494309189535);
      const float rr = (float)(a - k * 6.283185307179586);
      ct[e] = cosf(rr);
      st[e] = sinf(rr);
    }
  }
  {
    h16* h0 = (h16*)(ws + OFF_H0);
    const int nwv = gridDim.x * 4;
    const int rpw = (((M_TOK + nwv - 1) / nwv) + 3) & ~3;
    const int rbase = (blockIdx.x * 4 + (tid >> 6)) * rpw;
    float4 g[4];
#pragma unroll
    for (int i = 0; i < 4; i++) g[i] = ((const float4*)p.norm_a)[lane + 64 * i];
    for (int k = 0; k < rpw && rbase + k < M_TOK; k += 4) {
      float4 v[4][4];
#pragma unroll
      for (int u = 0; u < 4; u++) {
        const float4* xr = (const float4*)(p.x + (size_t)(rbase + k + u) * 1024);
#pragma unroll
        for (int i = 0; i < 4; i++) v[u][i] = xr[lane + 64 * i];
      }
#pragma unroll
      for (int u = 0; u < 4; u++) {
        float ss = 0.f;
#pragma unroll
        for (int i = 0; i < 4; i++) ss += v[u][i].x * v[u][i].x + v[u][i].y * v[u][i].y + v[u][i].z * v[u][i].z + v[u][i].w * v[u][i].w;
        ss = wave_sum(ss);
        const float rinv = rsqrtf(ss * (1.f / 1024.f) + 1e-6f);
#pragma unroll
        for (int i = 0; i < 4; i++) {
          h16x4 o;
          o[0] = (h16)(v[u][i].x * rinv * g[i].x);
          o[1] = (h16)(v[u][i].y * rinv * g[i].y);
          o[2] = (h16)(v[u][i].z * rinv * g[i].z);
          o[3] = (h16)(v[u][i].w * rinv * g[i].w);
          *(h16x4*)(h0 + (size_t)(rbase + k + u) * LD1K + (lane + 64 * i) * 4) = o;
        }
      }
    }
  }
}

constexpr int LROW = 144;
constexpr int MI = 4;
constexpr int GEMM_LDS = 384 * LROW;
template <bool SWAP, bool PIN = false>
DI void gemm_mainloop(const h16* __restrict__ A, int lda, const h16* __restrict__ Bt, int ldb, int K, int m0, int n0,
                      unsigned char* smem, f32x16 (&acc)[MI][2], int kstart = 0) {
  const int tid = ptid(), lane = tid & 63, w = tid >> 6;
  const int r = lane & 31, h = lane >> 5;
  const int wm = w >> 1, wn = w & 1;
  const int seg = tid & 7, lrow = tid >> 3;
  const unsigned char* Ab = (const unsigned char*)(A + (size_t)m0 * lda);
  const unsigned char* Bb = (const unsigned char*)(Bt + (size_t)n0 * ldb);
  const unsigned offa0 = (unsigned)(lrow * lda + seg * 8) * 2u, offb0 = (unsigned)(lrow * ldb + seg * 8) * 2u;
  int kcur = kstart;
  unsigned offa = offa0 + (unsigned)kcur * 128u, offb = offb0 + (unsigned)kcur * 128u;
  u32x4 st[12];
#pragma unroll
  for (int i = 0; i < 8; i++) st[i] = *(const u32x4*)(Ab + (size_t)i * 64 * lda + offa);
#pragma unroll
  for (int i = 0; i < 4; i++) st[8 + i] = *(const u32x4*)(Bb + (size_t)i * 64 * ldb + offb);
#pragma unroll
  for (int mi = 0; mi < MI; mi++)
#pragma unroll
    for (int ni = 0; ni < 2; ni++)
#pragma unroll
      for (int i = 0; i < 16; i++) acc[mi][ni][i] = 0.f;
  const int nk = K >> 6;
  unsigned char* wA = smem + lrow * LROW + seg * 16;
  const unsigned char* rA = smem + (wm * 128 + r) * LROW + h * 16;
  const unsigned char* rB = smem + (256 + wn * 64 + r) * LROW + h * 16;
  for (int kt = 0; kt < nk; kt++) {
#pragma unroll
    for (int i = 0; i < 12; i++) *(u32x4*)(wA + i * 32 * LROW) = st[i];
    __syncthreads();
    if (kt + 1 < nk) {
      kcur = (kcur + 1 == nk) ? 0 : kcur + 1;
      offa = offa0 + (unsigned)kcur * 128u;
      offb = offb0 + (unsigned)kcur * 128u;
#pragma unroll
      for (int i = 0; i < 8; i++) st[i] = *(const u32x4*)(Ab + (size_t)i * 64 * lda + offa);
#pragma unroll
      for (int i = 0; i < 4; i++) st[8 + i] = *(const u32x4*)(Bb + (size_t)i * 64 * ldb + offb);
    }
    if (PIN) __builtin_amdgcn_sched_barrier(0);
#pragma unroll
    for (int ks = 0; ks < 4; ks++) {
      h16x8 af[MI], bf[2];
#pragma unroll
      for (int mi = 0; mi < MI; mi++) af[mi] = *(const h16x8*)(rA + mi * 32 * LROW + ks * 32);
      bf[0] = *(const h16x8*)(rB + ks * 32);
      bf[1] = *(const h16x8*)(rB + 32 * LROW + ks * 32);
#pragma unroll
      for (int mi = 0; mi < MI; mi++)
#pragma unroll
        for (int ni = 0; ni < 2; ni++)
          acc[mi][ni] = SWAP ? MFMA(bf[ni], af[mi], acc[mi][ni]) : MFMA(af[mi], bf[ni], acc[mi][ni]);
    }
    __syncthreads();
  }
}


constexpr int STG_ROW = 144;
constexpr int STG_WAVE = 64 * STG_ROW;
DI void stage_put(unsigned char* wl, int r, int h, int ni, int gi, h16x4 o) {
  *(h16x4*)(wl + r * STG_ROW + (ni * 32 + 8 * gi + 4 * h) * 2) = o;
}
DI void stage_fence() {
  __builtin_amdgcn_fence(__ATOMIC_ACQ_REL, "wavefront");
  __builtin_amdgcn_wave_barrier();
}
DI void stage_flush(const unsigned char* wl, int lane, h16* grow0, size_t ld) {
  stage_fence();
#pragma unroll
  for (int k = 0; k < 4; k++) {
    const int idx = lane + 64 * k, row = idx >> 3, seg = idx & 7;
    const u32x4 v = *(const u32x4*)(wl + row * STG_ROW + seg * 16);
    *(u32x4*)(grow0 + (size_t)row * ld + seg * 8) = v;
  }
  stage_fence();
}

DI void phase1(const Params& p, unsigned char* smem) {
  unsigned char* ws = p.ws;
  const h16* A = (const h16*)(ws + OFF_H0);
  const h16* Bt = (const h16*)(ws + OFF_W1T);
  h16* xb = (h16*)(ws + OFF_XB);
  h16* sg = (h16*)(ws + OFF_SG);
  const int lane = ptid() & 63, w = ptid() >> 6, r = lane & 31, h = lane >> 5, wm = w >> 1, wn = w & 1;
  for (int t = vblock(); t < 128 * 20; t += gridDim.x) {
    const int m0 = (t / 20) * 256, n0 = (t % 20) * 128;
    f32x16 acc[MI][2];
    const int nb = n0 + wn * 64;
    if (n0 >= 1280) {
      gemm_mainloop<false>(A, LD1K, Bt, LD1K, 1024, m0, n0, smem, acc, (t * 5) & 15);
#pragma unroll
      for (int mi = 0; mi < MI; mi++)
#pragma unroll
        for (int ni = 0; ni < 2; ni++) {
          const int tb = (m0 + wm * 128 + mi * 32) >> 5, cb = (nb - 1280 + ni * 32) >> 5;
          h16x8 v0, v1;
#pragma unroll
          for (int i = 0; i < 8; i++) {
            v0[i] = (h16)silu_f(acc[mi][ni][i]);
            v1[i] = (h16)silu_f(acc[mi][ni][8 + i]);
          }
          h16* d = sg + (((size_t)tb * 40 + cb) * 64 + lane) * 16;
          *(h16x8*)d = v0;
          *(h16x8*)(d + 8) = v1;
        }
    } else {
      gemm_mainloop<true>(A, LD1K, Bt, LD1K, 1024, m0, n0, smem, acc, (t * 5) & 15);
      unsigned char* wl = smem + w * STG_WAVE;
#pragma unroll
      for (int mi = 0; mi < MI; mi++) {
#pragma unroll
        for (int ni = 0; ni < 2; ni++)
#pragma unroll
          for (int gi = 0; gi < 4; gi++) {
            h16x4 o;
#pragma unroll
            for (int j = 0; j < 4; j++) o[j] = (h16)acc[mi][ni][gi * 4 + j];
            stage_put(wl, r, h, ni, gi, o);
          }
        stage_flush(wl, lane, xb + (size_t)(m0 + wm * 128 + mi * 32) * 1280 + nb, 1280);
      }
    }
    __syncthreads();
  }
}

DI void phase2(const Params& p, unsigned char* smem) {
  unsigned char* ws = p.ws;
  const h16* xb = (const h16*)(ws + OFF_XB);
  const h16* sg = (const h16*)(ws + OFF_SG);
  h16* y = (h16*)(ws + OFF_Y);
  const h16* Wrg = (const h16*)(ws + OFF_WRG);
  const h16* Wig = (const h16*)(ws + OFF_WIG);
  h16* As = (h16*)smem;
  h16* cw_s = (h16*)(smem + 34816);
  h16* cb_s = (h16*)(smem + 36864);
  float* agg = (float*)(smem + 37376);
  h16* Ys = (h16*)(smem + 38400);
  const int tid = ptid(), lane = tid & 63, w = tid >> 6, r = lane & 31, h = lane >> 5;
  const float L2E = 1.44269504f;
  bool idle = false;
  for (int rk = 0; rk * (int)gridDim.x < 640; rk++) {
    const int it = round_item(rk, 640);
    if (it < 0) { idle = true; break; }
    const int b = it / 40, n = (it % 40) >> 2, q = it & 3;
    __syncthreads();
    if (tid < 128) {
      cb_s[tid] = (h16)p.conv_b[n * 128 + tid];
#pragma unroll
      for (int k = 0; k < 4; k++) cw_s[k * 128 + tid] = (h16)p.conv_w[k * 1280 + n * 128 + tid];
    }
    h16x8 brg[8], big[8];
    {
      const h16* wr = Wrg + (size_t)(n * 128 + q * 32 + r) * 128 + h * 8;
      const h16* wi = Wig + (size_t)(n * 128 + q * 32 + r) * 128 + h * 8;
#pragma unroll
      for (int ks = 0; ks < 8; ks++) {
        brg[ks] = *(const h16x8*)(wr + ks * 16);
        big[ks] = *(const h16x8*)(wi + ks * 16);
      }
    }
    const int ch = n * 128 + q * 32 + r;
    const float cbr = -L2E * p.b_rg[ch], cbi = -L2E * p.b_ig[ch];
    const float cch2 = -8.f * L2E * log1pf(expf(-p.lam[ch]));
    float hc = 0.f;
    const int cgp = tid & 15, rgp = tid >> 4;
    const h16* src = xb + ((size_t)(b * SEQ) + rgp * 8 - 3) * 1280 + n * 128 + cgp * 8;
    u32x4 xin[11];
#pragma unroll
    for (int j = 0; j < 11; j++) {
      if (rgp == 0 && j < 3) xin[j] = (u32x4){0u, 0u, 0u, 0u};
      else xin[j] = *(const u32x4*)(src + (ptrdiff_t)j * 1280);
    }
    __syncthreads();
    for (int c = 0; c < 16; c++) {
      {
        const h16x8 w0 = *(const h16x8*)(cw_s + 0 * 128 + cgp * 8), w1 = *(const h16x8*)(cw_s + 1 * 128 + cgp * 8);
        const h16x8 w2 = *(const h16x8*)(cw_s + 2 * 128 + cgp * 8), w3 = *(const h16x8*)(cw_s + 3 * 128 + cgp * 8);
        const h16x8 bb = *(const h16x8*)(cb_s + cgp * 8);
#pragma unroll
        for (int o = 0; o < 8; o++) {
          h16x8 a = w0 * __builtin_bit_cast(h16x8, xin[o]) + bb;
          a = w1 * __builtin_bit_cast(h16x8, xin[o + 1]) + a;
          a = w2 * __builtin_bit_cast(h16x8, xin[o + 2]) + a;
          a = w3 * __builtin_bit_cast(h16x8, xin[o + 3]) + a;
          *(h16x8*)(As + (rgp * 8 + o) * 136 + cgp * 8) = a;
        }
      }
      __syncthreads();
      if (c + 1 < 16) {
        const h16* s2 = src + (size_t)(c + 1) * 128 * 1280;
#pragma unroll
        for (int j = 0; j < 11; j++) xin[j] = *(const u32x4*)(s2 + (ptrdiff_t)j * 1280);
      }
      __builtin_amdgcn_sched_barrier(0);
      const int tb = (b * SEQ + c * 128 + w * 32) >> 5, cbk = n * 4 + q;
      const h16* sgp = sg + (((size_t)tb * 40 + cbk) * 64 + lane) * 16;
      const h16x8 sg0 = *(const h16x8*)sgp, sg1 = *(const h16x8*)(sgp + 8);
      f32x16 ar, ai;
#pragma unroll
      for (int i = 0; i < 16; i++) { ar[i] = 0.f; ai[i] = 0.f; }
      {
        const unsigned char* rA = (const unsigned char*)As + (w * 32 + r) * 272 + h * 16;
#pragma unroll
        for (int ks = 0; ks < 8; ks++) {
          const h16x8 a = *(const h16x8*)(rA + ks * 32);
          ar = MFMA(a, brg[ks], ar);
          ai = MFMA(a, big[ks], ai);
        }
      }
      float P[16], H[16], SA[4], SB[4];
#pragma unroll
      for (int gi = 0; gi < 4; gi++) {
        float pp = 1.f, hh = 0.f;
#pragma unroll
        for (int j = 0; j < 4; j++) {
          const int i = gi * 4 + j;
          const int tok = w * 32 + 8 * gi + 4 * h + j;
          const float xc = (float)As[tok * 136 + q * 32 + r];
          const float a1 = fminf(fmaf(ar[i], -L2E, cbr), 60.f), a2 = fminf(fmaf(ai[i], -L2E, cbi), 60.f);
          const float t1 = 1.f + fexp2(a1), t2 = 1.f + fexp2(a2);
          const float inv = frcp(t1 * t2);
          const float rs = t2 * inv, is = t1 * inv;
          const float a = fexp2(cch2 * rs);
          const float om = fmaf(-a, a, 1.f);
          const float bt = __builtin_amdgcn_sqrtf(om) * is * xc;
          hh = a * hh + bt;
          pp = a * pp;
          P[i] = pp;
          H[i] = hh;
        }
        SA[gi] = pp;
        SB[gi] = hh;
      }
      float CA = 1.f, CB = 0.f, inA[4], inB[4];
#pragma unroll
      for (int gi = 0; gi < 4; gi++) {
        const float oa = __shfl_xor(SA[gi], 32), ob = __shfl_xor(SB[gi], 32);
        const float a0 = h ? oa : SA[gi], b0 = h ? ob : SB[gi];
        const float a1 = h ? SA[gi] : oa, b1 = h ? SB[gi] : ob;
        const float ca0 = CA, cb0 = CB;
        CB = a0 * CB + b0;
        CA = a0 * CA;
        inA[gi] = h ? CA : ca0;
        inB[gi] = h ? CB : cb0;
        CB = a1 * CB + b1;
        CA = a1 * CA;
      }
      if (h == 0) {
        agg[(w * 32 + r) * 2] = CA;
        agg[(w * 32 + r) * 2 + 1] = CB;
      }
      __syncthreads();
      float hin = hc, hrun = hc;
#pragma unroll
      for (int w2 = 0; w2 < 4; w2++) {
        const float a = agg[(w2 * 32 + r) * 2], bb = agg[(w2 * 32 + r) * 2 + 1];
        if (w2 == w) hin = hrun;
        hrun = a * hrun + bb;
      }
      hc = hrun;
#pragma unroll
      for (int gi = 0; gi < 4; gi++) {
        const float hs = inA[gi] * hin + inB[gi];
#pragma unroll
        for (int j = 0; j < 4; j++) {
          const int i = gi * 4 + j;
          const int tok = w * 32 + 8 * gi + 4 * h + j;
          const float hv = H[i] + P[i] * hs;
          const float g = (float)(i < 8 ? sg0[i & 7] : sg1[i & 7]);
          Ys[tok * 40 + r] = (h16)(hv * g);
        }
      }
      __syncthreads();
#pragma unroll
      for (int k = 0; k < 2; k++) {
        const int idx = tid + 256 * k, row = idx >> 2, seg = idx & 3;
        *(u32x4*)(y + ((size_t)(b * SEQ + c * 128 + row)) * LDY + n * 128 + q * 32 + seg * 8) = *(const u32x4*)(Ys + row * 40 + seg * 8);
      }
    }
  }
  {
    const int G = gridDim.x, nbusy = 640 % G;
    __syncthreads();
    if (nbusy == 0) {
      for (int t = 720 + (int)blockIdx.x; t < 2000; t += G) convert_tile(p, t, (float*)smem);
    } else if (idle) {
      for (int t = 720 + ((int)blockIdx.x - nbusy); t < 2000; t += G - nbusy) convert_tile(p, t, (float*)smem);
    }
  }
}

DI void phase_res_gemm(const h16* __restrict__ A, int ld, int K, const h16* __restrict__ Bt, const float* __restrict__ res, float* __restrict__ outp, h16* __restrict__ outh, float* __restrict__ ssq,
                       unsigned char* smem) {
  const int lane = ptid() & 63, w = ptid() >> 6, r = lane & 31, h = lane >> 5, wm = w >> 1, wn = w & 1;
  for (int t = vblock(); t < 128 * 8; t += gridDim.x) {
    const int m0 = (t >> 3) * 256, n0 = (t & 7) * 128;
    f32x16 acc[MI][2];
    gemm_mainloop<true>(A, ld, Bt, ld, K, m0, n0, smem, acc);
    const int nb = n0 + wn * 64;
    unsigned char* wl = smem + w * STG_WAVE;
#pragma unroll
    for (int mi = 0; mi < MI; mi++) {
      const int rowb = m0 + wm * 128 + mi * 32;
      const int row = rowb + r;
#pragma unroll
      for (int k = 0; k < 8; k++) {
        const int idx = lane + 64 * k, rr = idx >> 4, sg4 = idx & 15;
        *(float4*)(wl + rr * 272 + sg4 * 16) = *(const float4*)(res + (size_t)(rowb + rr) * 1024 + nb + sg4 * 4);
      }
      stage_fence();
      float sq = 0.f;
      h16x4 ov[2][4];
#pragma unroll
      for (int ni = 0; ni < 2; ni++)
#pragma unroll
        for (int gi = 0; gi < 4; gi++) {
          float4 v = *(const float4*)(wl + r * 272 + (ni * 32 + 8 * gi + 4 * h) * 4);
          v.x += acc[mi][ni][gi * 4 + 0];
          v.y += acc[mi][ni][gi * 4 + 1];
          v.z += acc[mi][ni][gi * 4 + 2];
          v.w += acc[mi][ni][gi * 4 + 3];
          if (outp) *(float4*)(outp + (size_t)row * 1024 + nb + 4 * h + ni * 32 + 8 * gi) = v;
          ov[ni][gi][0] = (h16)v.x; ov[ni][gi][1] = (h16)v.y; ov[ni][gi][2] = (h16)v.z; ov[ni][gi][3] = (h16)v.w;
          sq += v.x * v.x + v.y * v.y + v.z * v.z + v.w * v.w;
        }
      stage_fence();
#pragma unroll
      for (int ni = 0; ni < 2; ni++)
#pragma unroll
        for (int gi = 0; gi < 4; gi++) stage_put(wl, r, h, ni, gi, ov[ni][gi]);
      stage_flush(wl, lane, outh + (size_t)rowb * LD1K + nb, LD1K);
      sq += __shfl_xor(sq, 32);
      if (h == 0) ssq[(size_t)row * 16 + (nb >> 6)] = sq;
    }
    __syncthreads();
  }
}

DI void phase_final(const Params& p, unsigned char* smem) {
  unsigned char* ws = p.ws;
  const h16* A = (const h16*)(ws + OFF_Y2);
  const h16* Bt = (const h16*)(ws + OFF_WOB);
  const h16* __restrict__ res = (const h16*)(ws + OFF_X1H);
  unsigned long long* tags = (unsigned long long*)(ws + OFF_TAGS);
  for (int t = vblock(); t < 128 * 8; t += gridDim.x) {
    const int m0 = (t >> 3) * 256, n0 = (t & 7) * 128;
    f32x16 acc[MI][2];
    gemm_mainloop<true>(A, LD1K, Bt, LD1K, 1024, m0, n0, smem, acc);
    const int te = ptid(), lane = te & 63, w = te >> 6, r = lane & 31, h = lane >> 5, wm = w >> 1, wn = w & 1;
    const int nb = n0 + wn * 64;
#pragma unroll
    for (int mi = 0; mi < MI; mi++) {
      const int row = m0 + wm * 128 + mi * 32 + r;
      float sq = 0.f;
      unsigned char* wlr = smem + w * STG_WAVE;
      {
        const h16* rsrc = res + (size_t)(m0 + wm * 128 + mi * 32) * LD1K + nb;
#pragma unroll
        for (int k = 0; k < 4; k++) {
          const int idx = lane + 64 * k, rr = idx >> 3, sg8 = idx & 7;
          *(u32x4*)(wlr + rr * STG_ROW + sg8 * 16) = *(const u32x4*)(rsrc + (size_t)rr * LD1K + sg8 * 8);
        }
        stage_fence();
      }
#pragma unroll
      for (int ni = 0; ni < 2; ni++)
#pragma unroll
        for (int gi = 0; gi < 4; gi++) {
          const h16x4 v = *(const h16x4*)(wlr + r * STG_ROW + (ni * 32 + 8 * gi + 4 * h) * 2);
#pragma unroll
          for (int j = 0; j < 4; j++) acc[mi][ni][gi * 4 + j] += (float)v[j];
#pragma unroll
          for (int j = 0; j < 4; j++) sq += acc[mi][ni][gi * 4 + j] * acc[mi][ni][gi * 4 + j];
        }
      stage_fence();
      sq += __shfl_xor(sq, 32);
      if (h == 0) {
        const unsigned long long pk = (unsigned long long)__float_as_uint(sq) | (1ull << 32);
        __hip_atomic_store(tags + (size_t)row * 16 + (nb >> 6), pk, __ATOMIC_RELAXED, __HIP_MEMORY_SCOPE_AGENT);
      }
    }
#pragma unroll
    for (int mi = 0; mi < MI; mi++) {
      const int row = m0 + wm * 128 + mi * 32 + r;
      float tot = 0.f;
#pragma unroll
      for (int k = 0; k < 8; k++) {
        unsigned long long* tp = tags + (size_t)row * 16 + 8 * h + k;
        unsigned long long v = __hip_atomic_load(tp, __ATOMIC_RELAXED, __HIP_MEMORY_SCOPE_AGENT);
        unsigned spin = 0;
        while ((unsigned)(v >> 32) != 1u && spin < (1u << 22)) {
          __builtin_amdgcn_s_sleep(1);
          v = __hip_atomic_load(tp, __ATOMIC_RELAXED, __HIP_MEMORY_SCOPE_AGENT);
          ++spin;
        }
        tot += __uint_as_float((unsigned)v);
      }
      tot += __shfl_xor(tot, 32);
      const float rinv = rsqrtf(tot * (1.f / 1024.f) + 1e-6f);
      unsigned char* wl = smem + w * STG_WAVE;
#pragma unroll
      for (int ni = 0; ni < 2; ni++)
#pragma unroll
        for (int gi = 0; gi < 4; gi++) {
          const float4 g = *(const float4*)(p.final_norm + nb + 4 * h + ni * 32 + 8 * gi);
          float4 o;
          o.x = acc[mi][ni][gi * 4 + 0] * rinv * g.x;
          o.y = acc[mi][ni][gi * 4 + 1] * rinv * g.y;
          o.z = acc[mi][ni][gi * 4 + 2] * rinv * g.z;
          o.w = acc[mi][ni][gi * 4 + 3] * rinv * g.w;
          *(float4*)(wl + r * 272 + (ni * 32 + 8 * gi + 4 * h) * 4) = o;
        }
      stage_fence();
      const int rowb = m0 + wm * 128 + mi * 32;
#pragma unroll
      for (int k = 0; k < 8; k++) {
        const int idx = lane + 64 * k, rr = idx >> 4, sg4 = idx & 15;
        *(float4*)(p.out + (size_t)(rowb + rr) * 1024 + nb + sg4 * 4) = *(const float4*)(wl + rr * 272 + sg4 * 16);
      }
      stage_fence();
    }
    __syncthreads();
  }
}

DI void phase4(const Params& p, unsigned char* smem) {
  unsigned char* ws = p.ws;
  const h16* A = (const h16*)(ws + OFF_X1H);
  const h16* Bt = (const h16*)(ws + OFF_W4T);
  const float* ssq = (const float*)(ws + OFF_SSQX1);
  h16* ckv = (h16*)(ws + OFF_CKV);
  h16* cq = (h16*)(ws + OFF_CQ);
  h16* sg2 = (h16*)(ws + OFF_SG2);
  h16* Kf = (h16*)(ws + OFF_KF);
  float* ssqkv = (float*)(ws + OFF_SSQKV);
  float* ssqq = (float*)(ws + OFF_SSQQ);
  const float* ct = (const float*)(ws + OFF_COS);
  const float* st = (const float*)(ws + OFF_SIN);
  float* rinv_s = (float*)(smem + GEMM_LDS);
  const int tid = ptid(), lane = tid & 63, w = tid >> 6, r = lane & 31, h = lane >> 5, wm = w >> 1, wn = w & 1;
  for (int base = 0; base < 128 * 14; base += gridDim.x) {
    const int t = base + ((base + (int)gridDim.x <= 128 * 14) ? vblock() : (int)blockIdx.x);
    if (t >= 128 * 14) break;
    const int m0 = (t / 14) * 256, n0 = (t % 14) * 128;
    {
      const float4* sp = (const float4*)(ssq + (size_t)(m0 + tid) * 16);
      float s = 0.f;
#pragma unroll
      for (int i = 0; i < 4; i++) { const float4 v = sp[i]; s += v.x + v.y + v.z + v.w; }
      rinv_s[tid] = rsqrtf(s * (1.f / 1024.f) + 1e-6f);
    }
    f32x16 acc[MI][2];
    gemm_mainloop<true>(A, LD1K, Bt, LD1K, 1024, m0, n0, smem, acc);
    const int nb = n0 + wn * 64;
    const int sub = nb >> 6;
    const int lr0 = wm * 128 + r;
    const int row0 = m0 + lr0;
    unsigned char* wl = smem + w * STG_WAVE;
    const int rowt = m0 + wm * 128;
    if (sub < 10) {
      const bool iskv = sub < 4;
      h16* gb = iskv ? ckv + (size_t)rowt * LDKV + nb : cq + (size_t)rowt * 384 + (nb - 256);
      const int ld = iskv ? LDKV : 384;
      float* sqb = iskv ? ssqkv + (size_t)row0 * 4 + sub : ssqq + (size_t)row0 * 8 + (sub - 4);
      const int sld = iskv ? 4 : 8;
#pragma unroll
      for (int mi = 0; mi < MI; mi++) {
        const float ri = rinv_s[lr0 + mi * 32];
        float sq = 0.f;
#pragma unroll
        for (int ni = 0; ni < 2; ni++)
#pragma unroll
          for (int gi = 0; gi < 4; gi++) {
            h16x4 o;
#pragma unroll
            for (int j = 0; j < 4; j++) {
              const float v = acc[mi][ni][gi * 4 + j] * ri;
              o[j] = (h16)v;
              sq += v * v;
            }
            stage_put(wl, r, h, ni, gi, o);
          }
        stage_flush(wl, lane, gb + (size_t)mi * 32 * ld, ld);
        sq += __shfl_xor(sq, 32);
        if (h == 0) sqb[mi * 32 * sld] = sq;
      }
    } else if (sub < 26) {
      h16* gb = sg2 + (size_t)rowt * 1024 + (nb - 640);
#pragma unroll
      for (int mi = 0; mi < MI; mi++) {
        const float ri = rinv_s[lr0 + mi * 32];
#pragma unroll
        for (int ni = 0; ni < 2; ni++)
#pragma unroll
          for (int gi = 0; gi < 4; gi++) {
            h16x4 o;
#pragma unroll
            for (int j = 0; j < 4; j++) o[j] = (h16)silu_f(acc[mi][ni][gi * 4 + j] * ri);
            stage_put(wl, r, h, ni, gi, o);
          }
        stage_flush(wl, lane, gb + (size_t)mi * 32 * 1024, 1024);
      }
    } else if (sub == 26) {
      const int b = m0 >> 11, s0 = (m0 & 2047) + lr0;
#pragma unroll
      for (int mi = 0; mi < MI; mi++) {
        const float ri = rinv_s[lr0 + mi * 32];
        const int s = s0 + mi * 32;
#pragma unroll
        for (int gi = 0; gi < 4; gi++) {
          const int j0 = 8 * gi + 4 * h;
          const float4 c = *(const float4*)(ct + s * 32 + j0);
          const float4 sn = *(const float4*)(st + s * 32 + j0);
          const float cc[4] = {c.x, c.y, c.z, c.w}, ss[4] = {sn.x, sn.y, sn.z, sn.w};
          h16x4 o1, o2;
#pragma unroll
          for (int j = 0; j < 4; j++) {
            const float x1 = acc[mi][0][gi * 4 + j] * ri, x2 = acc[mi][1][gi * 4 + j] * ri;
            o1[j] = (h16)(x1 * cc[j] - x2 * ss[j]);
            o2[j] = (h16)(x2 * cc[j] + x1 * ss[j]);
          }
          stage_put(wl, r, h, 0, gi, o1);
          stage_put(wl, r, h, 1, gi, o2);
        }
        stage_fence();
        u32x4 vv[4];
#pragma unroll
        for (int k = 0; k < 4; k++) {
          const int idx = lane + 64 * k;
          vv[k] = *(const u32x4*)(wl + (idx >> 3) * STG_ROW + (idx & 7) * 16);
        }
        const int st0 = (m0 & 2047) + wm * 128 + mi * 32;
#pragma unroll 1
        for (int hd = 0; hd < 8; hd++) {
          h16* kp = Kf + ((size_t)(b * 8 + hd) * SEQ + st0) * 192 + 128;
#pragma unroll
          for (int k = 0; k < 4; k++) {
            const int idx = lane + 64 * k;
            *(u32x4*)(kp + (size_t)(idx >> 3) * 192 + (idx & 7) * 8) = vv[k];
          }
        }
        stage_fence();
      }
    }
    __syncthreads();
  }
}

template <bool ISQ>
DI void phase5_part(const Params& p, unsigned char* smem) {
  unsigned char* ws = p.ws;
  const h16* ckv = (const h16*)(ws + OFF_CKV);
  const h16* cq = (const h16*)(ws + OFF_CQ);
  const h16* Wkv = (const h16*)(ws + OFF_W5KV);
  const h16* Wq = (const h16*)(ws + OFF_W5Q);
  const float* ssqkv = (const float*)(ws + OFF_SSQKV);
  const float* ssqq = (const float*)(ws + OFF_SSQQ);
  h16* Kf = (h16*)(ws + OFF_KF);
  h16* Vt = (h16*)(ws + OFF_VT);
  h16* Q = (h16*)(ws + OFF_Q);
  const float* ct = (const float*)(ws + OFF_COS);
  const float* st = (const float*)(ws + OFF_SIN);
  float* rinv_s = (float*)(smem + GEMM_LDS);
  const int tid = ptid(), lane = tid & 63, w = tid >> 6, r = lane & 31, h = lane >> 5, wm = w >> 1, wn = w & 1;
  const float qscale = 0.07216878364870322f * 1.4426950408889634f;
  constexpr int NTT = ISQ ? 12 : 16;
  for (int t = vblock(); t < 128 * NTT; t += gridDim.x) {
    const int mt = t / NTT, nt = (t % NTT) + (ISQ ? 16 : 0);
    const int m0 = mt * 256;
    const int bb = m0 >> 11;
    const int lr0 = wm * 128 + 4 * h;
    const int s0 = (m0 & 2047) + lr0;
    f32x16 acc[MI][2];
    constexpr bool is_q = ISQ;
    const bool is_v = (nt >= 8) && !is_q;
    {
      float rv;
      if (!is_q) {
        const float4 v = *(const float4*)(ssqkv + (size_t)(m0 + tid) * 4);
        rv = rsqrtf((v.x + v.y + v.z + v.w) * (1.f / 256.f) + 1e-6f);
      } else {
        const float4* sp = (const float4*)(ssqq + (size_t)(m0 + tid) * 8);
        const float4 v0 = sp[0], v1 = sp[1];
        rv = rsqrtf((v0.x + v0.y + v0.z + v0.w + v1.x + v1.y) * (1.f / 384.f) + 1e-6f) * qscale;
      }
      rinv_s[tid] = rv;
    }
    const h16* Ap = is_q ? cq : ckv;
    const h16* Bp = is_q ? Wq : Wkv;
    constexpr int Kd = is_q ? 384 : 256;
    constexpr int ldk = is_q ? 384 : LDKV;
    const int n0 = is_q ? (nt - 16) * 128 : nt * 128;
    gemm_mainloop<true, false>(Ap, ldk, Bp, ldk, Kd, m0, n0, smem, acc);
    const int lrw = wm * 128 + r;
    const int sw = (m0 & 2047) + lrw;
    unsigned char* wl = smem + w * STG_WAVE;
    const int st0 = (m0 & 2047) + wm * 128;
    if (!is_v) {
      const int sub = (n0 >> 6) + wn;
      const int hd = is_q ? sub / 3 : nt;
      const int part = is_q ? sub % 3 : wn;
      h16* gb = (is_q ? Q : Kf) + ((size_t)(bb * 8 + hd) * SEQ + st0) * 192 + part * 64;
      if (!is_q || part < 2) {
#pragma unroll
        for (int mi = 0; mi < MI; mi++) {
          const float ri = rinv_s[lrw + mi * 32];
#pragma unroll
          for (int ni = 0; ni < 2; ni++)
#pragma unroll
            for (int gi = 0; gi < 4; gi++) {
              h16x4 o;
#pragma unroll
              for (int j = 0; j < 4; j++) o[j] = (h16)(acc[mi][ni][gi * 4 + j] * ri);
              stage_put(wl, r, h, ni, gi, o);
            }
          stage_flush(wl, lane, gb + (size_t)mi * 32 * 192, 192);
        }
      } else {
#pragma unroll
        for (int mi = 0; mi < MI; mi++) {
          const float ri = rinv_s[lrw + mi * 32];
          const int s = sw + mi * 32;
#pragma unroll
          for (int gi = 0; gi < 4; gi++) {
            const int j0 = 8 * gi + 4 * h;
            const float4 c = *(const float4*)(ct + s * 32 + j0);
            const float4 sn = *(const float4*)(st + s * 32 + j0);
            const float cc[4] = {c.x, c.y, c.z, c.w}, ss[4] = {sn.x, sn.y, sn.z, sn.w};
            h16x4 o1, o2;
#pragma unroll
            for (int j = 0; j < 4; j++) {
              const float x1 = acc[mi][0][gi * 4 + j] * ri, x2 = acc[mi][1][gi * 4 + j] * ri;
              o1[j] = (h16)(x1 * cc[j] - x2 * ss[j]);
              o2[j] = (h16)(x2 * cc[j] + x1 * ss[j]);
            }
            stage_put(wl, r, h, 0, gi, o1);
            stage_put(wl, r, h, 1, gi, o2);
          }
          stage_flush(wl, lane, gb + (size_t)mi * 32 * 192, 192);
        }
      }
    } else {
#pragma unroll
      for (int mp = 0; mp < 2; mp++) {
#pragma unroll
        for (int m2 = 0; m2 < 2; m2++) {
          const int mi = mp * 2 + m2;
          const float ri = rinv_s[lrw + mi * 32];
          const int t = m2 * 32 + r;
          const int pos = (t & ~15) + 8 * ((t >> 2) & 1) + 4 * ((t >> 3) & 1) + (t & 3);
#pragma unroll
          for (int ni = 0; ni < 2; ni++)
#pragma unroll
            for (int i = 0; i < 16; i++)
              *(h16*)(wl + (ni * 32 + crow(i, h)) * STG_ROW + pos * 2) = (h16)(acc[mi][ni][i] * ri);
        }
        stage_fence();
        const int kt = (st0 + mp * 64) >> 6;
        h16* gv = Vt + (((size_t)(bb * 8 + (nt - 8)) * 32 + kt) * 128 + wn * 64) * 64;
#pragma unroll
        for (int k = 0; k < 8; k++) {
          const int idx = lane + 64 * k, row = idx >> 3, seg = idx & 7;
          *(u32x4*)(gv + row * 64 + seg * 8) = *(const u32x4*)(wl + row * STG_ROW + seg * 16);
        }
        stage_fence();
      }
    }
    __syncthreads();
  }
}

DI void phase5(const Params& p, unsigned char* smem) {
  phase5_part<false>(p, smem);
  phase5_part<true>(p, smem);
}

constexpr int KROW = 400;
constexpr int VROW = 144;
DI void phase6(const Params& p, unsigned char* smem) {
  unsigned char* ws = p.ws;
  const h16* Q = (const h16*)(ws + OFF_Q);
  const h16* Kf = (const h16*)(ws + OFF_KF);
  const h16* Vt = (const h16*)(ws + OFF_VT);
  const h16* sg2 = (const h16*)(ws + OFF_SG2);
  h16* y2 = (h16*)(ws + OFF_Y2);
  unsigned char* Ks = smem;
  unsigned char* Vs = smem + 64 * KROW;
  const int tid = ptid(), lane = tid & 63, w = tid >> 6, r = lane & 31, h = lane >> 5;
  for (int it2 = vblock() * 2; it2 < 2048; it2 += gridDim.x * 2)
  for (int sel = 0; sel < 2; sel++) {
    const int bh = it2 >> 4, xx = (it2 >> 1) & 7;
    const int qb = sel ? xx : 15 - xx;
    const int b = bh >> 3, hd = bh & 7;
    const int qrow = qb * 128 + w * 32 + r;
    h16x8 qf[12];
    {
      const h16* qp = Q + ((size_t)bh * SEQ + qrow) * 192 + h * 8;
#pragma unroll
      for (int ks = 0; ks < 12; ks++) qf[ks] = *(const h16x8*)(qp + ks * 16);
    }
    f32x16 O[4];
#pragma unroll
    for (int dt = 0; dt < 4; dt++)
#pragma unroll
      for (int i = 0; i < 16; i++) O[dt][i] = 0.f;
    float m = -INFINITY, l = 0.f;
    const int nkt = 2 * qb + 2;
    const h16* kbase = Kf + (size_t)bh * SEQ * 192;
    const h16* vbase = Vt + (size_t)bh * 128 * SEQ;
    u32x4 kst[6], vst[4];
    const h16* kg = kbase + (size_t)(tid >> 3) * 192 + (tid & 7) * 8;
    const h16* vg = vbase + (size_t)(tid >> 3) * 64 + (tid & 7) * 8;
    unsigned char* kw = Ks + (tid >> 3) * KROW + (tid & 7) * 16;
    unsigned char* vw = Vs + (tid >> 3) * VROW + (tid & 7) * 16;
#pragma unroll
    for (int i = 0; i < 6; i++) kst[i] = *(const u32x4*)(kg + (i & 1) * 32 * 192 + (i >> 1) * 64);
#pragma unroll
    for (int i = 0; i < 4; i++) vst[i] = *(const u32x4*)(vg + (size_t)i * 32 * 64);
    for (int kt = 0; kt < nkt; kt++) {
#pragma unroll
      for (int i = 0; i < 6; i++) *(u32x4*)(kw + (i & 1) * 32 * KROW + (i >> 1) * 128) = kst[i];
#pragma unroll
      for (int i = 0; i < 4; i++) *(u32x4*)(vw + i * 32 * VROW) = vst[i];
      __syncthreads();
      if (kt + 1 < nkt) {
        kg += 64 * 192;
        vg += 8192;
#pragma unroll
        for (int i = 0; i < 6; i++) kst[i] = *(const u32x4*)(kg + (i & 1) * 32 * 192 + (i >> 1) * 64);
#pragma unroll
        for (int i = 0; i < 4; i++) vst[i] = *(const u32x4*)(vg + (size_t)i * 32 * 64);
      }
#pragma unroll
      for (int half = 0; half < 2; half++) {
        const int sb = (kt - (nkt - 2)) * 2 + half;
        if (sb > w) continue;
        f32x16 sc;
#pragma unroll
        for (int i = 0; i < 16; i++) sc[i] = 0.f;
        const unsigned char* kr = Ks + (half * 32 + r) * KROW + h * 16;
#pragma unroll
        for (int g = 0; g < 3; g++) {
          h16x8 kf[4];
#pragma unroll
          for (int j = 0; j < 4; j++) kf[j] = *(const h16x8*)(kr + (g * 4 + j) * 32);
#pragma unroll
          for (int j = 0; j < 4; j++) sc = MFMA(kf[j], qf[g * 4 + j], sc);
        }
        if (sb == w) {
#pragma unroll
          for (int i = 0; i < 16; i++)
            if (crow(i, h) > r) sc[i] = -INFINITY;
        }
        float mx = sc[0];
#pragma unroll
        for (int i = 1; i < 16; i++) mx = fmaxf(mx, sc[i]);
        mx = fmaxf(mx, __shfl_xor(mx, 32));
        const float mn = fmaxf(m, mx);
        if (__builtin_amdgcn_ballot_w64(mn > m) != 0ull) {
          const float alpha = fexp2(m - mn);
          m = mn;
          l *= alpha;
#pragma unroll
          for (int dt = 0; dt < 4; dt++)
#pragma unroll
            for (int i = 0; i < 16; i++) O[dt][i] *= alpha;
        }
        float ls = 0.f;
#pragma unroll
        for (int i = 0; i < 16; i++) {
          sc[i] = fexp2(sc[i] - m);
          ls += sc[i];
        }
        l += ls;
        h16x8 pf0, pf1;
#pragma unroll
        for (int jj = 0; jj < 8; jj++) {
          pf0[jj] = (h16)sc[jj];
          pf1[jj] = (h16)sc[8 + jj];
        }
        const unsigned char* vr = Vs + r * VROW + h * 16 + half * 64;
#pragma unroll
        for (int dp = 0; dp < 2; dp++) {
          h16x8 vf[4];
#pragma unroll
          for (int j = 0; j < 4; j++) vf[j] = *(const h16x8*)(vr + (dp * 2 + (j >> 1)) * 32 * VROW + (j & 1) * 32);
#pragma unroll
          for (int j = 0; j < 4; j++) O[dp * 2 + (j >> 1)] = MFMA(vf[j], (j & 1) ? pf1 : pf0, O[dp * 2 + (j >> 1)]);
        }
      }
      __syncthreads();
    }
    l += __shfl_xor(l, 32);
    const float inv = 1.f / l;
    {
      unsigned char* wl = smem + w * STG_WAVE;
      const int rowb = b * SEQ + qb * 128 + w * 32;
#pragma unroll
      for (int dp = 0; dp < 2; dp++) {
        const h16* gsrc = sg2 + (size_t)rowb * 1024 + hd * 128 + dp * 64;
#pragma unroll
        for (int k = 0; k < 4; k++) {
          const int idx = lane + 64 * k, rr = idx >> 3, sg8 = idx & 7;
          *(u32x4*)(wl + rr * STG_ROW + sg8 * 16) = *(const u32x4*)(gsrc + (size_t)rr * 1024 + sg8 * 8);
        }
        stage_fence();
        h16x4 ov[2][4];
#pragma unroll
        for (int ni = 0; ni < 2; ni++)
#pragma unroll
          for (int gi = 0; gi < 4; gi++) {
            const h16x4 gt = *(const h16x4*)(wl + r * STG_ROW + (ni * 32 + 8 * gi + 4 * h) * 2);
#pragma unroll
            for (int jj = 0; jj < 4; jj++) ov[ni][gi][jj] = (h16)(O[dp * 2 + ni][gi * 4 + jj] * inv * (float)gt[jj]);
          }
        stage_fence();
#pragma unroll
        for (int ni = 0; ni < 2; ni++)
#pragma unroll
          for (int gi = 0; gi < 4; gi++) stage_put(wl, r, h, ni, gi, ov[ni][gi]);
        stage_flush(wl, lane, y2 + (size_t)rowb * LD1K + hd * 128 + dp * 64, LD1K);
      }
    }
    __syncthreads();
  }
}

DI void phase8(const Params& p) {
  const float* ssq = (const float*)(p.ws + OFF_SSQO);
  const int tid = ptid(), lane = tid & 63;
  const int nw = gridDim.x * 4;
  for (int row = blockIdx.x * 4 + (tid >> 6); row < M_TOK; row += nw) {
    const float4* sp = (const float4*)(ssq + (size_t)row * 16);
    float s = 0.f;
#pragma unroll
    for (int i = 0; i < 4; i++) { const float4 v = sp[i]; s += v.x + v.y + v.z + v.w; }
    const float rinv = rsqrtf(s * (1.f / 1024.f) + 1e-6f);
    const float4* xr = (const float4*)((const float*)(p.ws + OFF_X2) + (size_t)row * 1024);
    float4* orow = (float4*)(p.out + (size_t)row * 1024);
#pragma unroll
    for (int i = 0; i < 4; i++) {
      float4 v = xr[lane + 64 * i];
      const float4 g = ((const float4*)p.final_norm)[lane + 64 * i];
      v.x *= rinv * g.x; v.y *= rinv * g.y; v.z *= rinv * g.z; v.w *= rinv * g.w;
      orow[lane + 64 * i] = v;
    }
  }
}

#define XB_TMO      128
#define XB_XCNT(j)  (256  + 64 * (j))
#define XB_XSUB(j)  (1280 + 64 * (j))
#define XB_XGEN(j)  (2304 + 64 * (j))
#define XB_TOP      3328
#define XB_TOPGEN   3392
#define XCD_BAR_WORDS 3456
#define XB_SPIN_CAP (1u << 18)
#define LAS __attribute__((address_space(3)))
DI unsigned xb_ld(unsigned* p) { return __hip_atomic_load(p, __ATOMIC_RELAXED, __HIP_MEMORY_SCOPE_AGENT); }
DI unsigned xb_add(unsigned* p, unsigned v) { return __hip_atomic_fetch_add(p, v, __ATOMIC_RELAXED, __HIP_MEMORY_SCOPE_AGENT); }
DI unsigned xb_xcc_id() { return (unsigned)__builtin_amdgcn_s_getreg((3 << 11) | 20) & 0xFu; }
#define XB_SPIN(cond, bar) do { unsigned _sp = 0; while (cond) { __builtin_amdgcn_s_sleep(1); \
    if ((++_sp & 255u) == 0u) { if (xb_ld(&(bar)[XB_TMO])) break; if (_sp > XB_SPIN_CAP) { atomicAdd(&(bar)[XB_TMO], 1u); break; } } } } while (0)
struct XcdBarrier { unsigned* bar; unsigned x; volatile LAS unsigned* st; };
DI XcdBarrier xcd_barrier_post(unsigned* bar, volatile LAS unsigned* st) {
  XcdBarrier b; b.bar = bar; b.x = xb_xcc_id(); b.st = st;
  if (threadIdx.x == 0) (void)xb_add(&bar[XB_XCNT(b.x)], 1u);
  return b;
}
DI void xcd_barrier_complete(unsigned* bar, unsigned x, unsigned& nloc, unsigned& nx) {
  const unsigned G = gridDim.x;
  unsigned sum, cnt, mine, sp = 0u;
  for (;;) {
    sum = 0u; cnt = 0u; mine = 0u;
#pragma unroll
    for (unsigned j = 0; j < 16; ++j) { const unsigned c = xb_ld(&bar[XB_XCNT(j)]); sum += c; cnt += (c > 0u) ? 1u : 0u; mine = (j == x) ? c : mine; }
    if (sum == G) break;
    __builtin_amdgcn_s_sleep(1);
    if ((++sp & 255u) == 0u) { if (xb_ld(&bar[XB_TMO])) break; if (sp > XB_SPIN_CAP) { atomicAdd(&bar[XB_TMO], 1u); break; } }
  }
  nloc = mine > 0u ? mine : 1u; nx = cnt > 0u ? cnt : 1u;
}
DI void xcd_barrier(const XcdBarrier& b) {
  asm volatile("s_waitcnt vmcnt(0)" ::: "memory");
  __syncthreads();
  if (threadIdx.x == 0) {
    unsigned* bar = b.bar;
    __builtin_amdgcn_s_waitcnt(0);
    unsigned nloc = b.st[0], nx = b.st[1];
    if (nloc == 0u) { xcd_barrier_complete(bar, b.x, nloc, nx); b.st[0] = nloc; b.st[1] = nx; }
    const unsigned old = xb_add(&bar[XB_XSUB(b.x)], 1u);
    const unsigned gen = old / nloc;
    if (old + 1u == (gen + 1u) * nloc) {
      __builtin_amdgcn_fence(__ATOMIC_RELEASE, "agent");
      asm volatile("s_waitcnt vmcnt(0)" ::: "memory");
      const unsigned og = xb_add(&bar[XB_TOP], 1u);
      const unsigned tg = og / nx;
      if (og + 1u == (tg + 1u) * nx) xb_add(&bar[XB_TOPGEN], 1u);
      else XB_SPIN(xb_ld(&bar[XB_TOPGEN]) == tg, bar);
      __builtin_amdgcn_fence(__ATOMIC_ACQUIRE, "agent");
      xb_add(&bar[XB_XGEN(b.x)], 1u);
      asm volatile("s_waitcnt vmcnt(0)" ::: "memory");
    } else {
      XB_SPIN(xb_ld(&bar[XB_XGEN(b.x)]) == gen, bar);
      __builtin_amdgcn_fence(__ATOMIC_ACQUIRE, "agent");
      asm volatile("s_waitcnt vmcnt(0)" ::: "memory");
    }
  }
  __syncthreads();
}

constexpr int SMEM_BYTES = 56320;
__global__ void __launch_bounds__(256, 2) yoco_fwd(Params p) {
  __shared__ __attribute__((aligned(16))) unsigned char smem[SMEM_BYTES];
  __shared__ uint4 xb_words;
  unsigned char* ws = p.ws;
  if (threadIdx.x == 0) xb_words = make_uint4(0u, 0u, 0u, 0u);
  __syncthreads();
  const XcdBarrier xb = xcd_barrier_post((unsigned*)(ws + OFF_BAR), (volatile LAS unsigned*)&xb_words);
  if (p.out == nullptr) {
    const unsigned long long mg = *(const volatile unsigned long long*)((const char*)__builtin_amdgcn_implicitarg_ptr() + 88);
    if (mg == 1ull) ((volatile unsigned*)(ws + OFF_BAR))[XB_TMO] = 1u;
  }
#ifndef DUP
#define DUP 0
#endif
#ifndef PHM
#define PHM 0xfff
#endif
#define RUNP(bit, call) { if (PHM & bit) { call; } xcd_barrier(xb); if (DUP & bit) { call; xcd_barrier(xb); } }
  RUNP(1, phase0(p, smem))
  RUNP(2, phase1(p, smem))
  RUNP(4, phase2(p, smem))
  RUNP(8, phase_res_gemm((const h16*)(ws + OFF_Y), LDY, 1280, (const h16*)(ws + OFF_WOA), p.x, nullptr, (h16*)(ws + OFF_X1H), (float*)(ws + OFF_SSQX1), smem))
  RUNP(16, phase4(p, smem))
  RUNP(32, phase5(p, smem))
  RUNP(64, phase6(p, smem))
  if (PHM & 128) phase_final(p, smem);
}

extern "C" void kernel_launch(void* const* d_in, const int* in_sizes, int n_in, void* d_out, int out_size, void* d_ws,
                              size_t ws_size, hipStream_t stream) {
  static int grid_blocks = 0;
  static int cus_s = 0;
  if (!grid_blocks) {
    int dev = 0, cus = 0;
    (void)hipGetDevice(&dev);
    (void)hipDeviceGetAttribute(&cus, hipDeviceAttributeMultiprocessorCount, dev);
    if (cus < 8) cus = 256;
    cus -= cus % 8;
    cus_s = cus;
    grid_blocks = cus * 2;
  }
  Params p{};
  const float** pp = (const float**)&p;
  for (int i = 0; i < 22; i++) pp[i] = (const float*)d_in[i];
  p.out = (float*)d_out;
  p.ws = (unsigned char*)d_ws;
  (void)hipMemsetAsync((unsigned char*)d_ws + OFF_BAR, 0, XCD_BAR_WORDS * sizeof(unsigned), stream);
  void* args[] = {&p};
  hipError_t e = hipLaunchCooperativeKernel((void*)yoco_fwd, dim3(grid_blocks), dim3(256), args, 0, stream);
  if (e != hipSuccess && grid_blocks != cus_s) {
    (void)hipGetLastError();
    grid_blocks = cus_s;
    e = hipLaunchCooperativeKernel((void*)yoco_fwd, dim3(grid_blocks), dim3(256), args, 0, stream);
  }
  if (e != hipSuccess) fprintf(stderr, "cooperative launch failed: %s (grid %d)\n", hipGetErrorString(e), grid_blocks);
}
```

```cpp
#include <hip/hip_runtime.h>
#include <hip/hip_cooperative_groups.h>
#include <cstdio>
namespace cg = cooperative_groups;

typedef _Float16 h16;
typedef __attribute__((ext_vector_type(8))) _Float16 h16x8;
typedef __attribute__((ext_vector_type(4))) _Float16 h16x4;
typedef __attribute__((ext_vector_type(16))) float f32x16;
typedef __attribute__((ext_vector_type(4))) unsigned u32x4;

#define DI __device__ __forceinline__
#define MFMA(a, b, c) __builtin_amdgcn_mfma_f32_32x32x16_f16((a), (b), (c), 0, 0, 0)

constexpr int M_TOK = 32768;
constexpr int SEQ = 2048;
constexpr size_t MiB = 1u << 20;
constexpr int LD1K = 1088;
constexpr int LDY = 1344;
constexpr int LDKV = 320;
constexpr size_t OFF_W1T = 0;
constexpr size_t OFF_WRG = 5 * MiB + 512 * 1024;
constexpr size_t OFF_WIG = 6 * MiB;
constexpr size_t OFF_WOA = 6 * MiB + 512 * 1024;
constexpr size_t OFF_W4T = 9 * MiB + 512 * 1024;
constexpr size_t OFF_W5KV = 13 * MiB + 512 * 1024;
constexpr size_t OFF_W5Q = 15 * MiB;
constexpr size_t OFF_WOB = 16 * MiB + 512 * 1024;
constexpr size_t OFF_COS = 19 * MiB;
constexpr size_t OFF_SIN = OFF_COS + 256 * 1024;
constexpr size_t OFF_SSQX1 = 19 * MiB + 512 * 1024;
constexpr size_t OFF_SSQKV = 21 * MiB + 512 * 1024;
constexpr size_t OFF_SSQQ = 22 * MiB;
constexpr size_t OFF_SSQO = 23 * MiB;
constexpr size_t OFF_BAR = 25 * MiB;
constexpr size_t SLOT1 = 26 * MiB;
constexpr size_t SLOT2 = 110 * MiB;
constexpr size_t SLOT3 = 270 * MiB;
constexpr size_t OFF_H0 = SLOT1, OFF_Y = SLOT1, OFF_CKV = SLOT1, OFF_CQ = SLOT1 + 24 * MiB, OFF_Y2 = SLOT1;
constexpr size_t OFF_XB = SLOT2, OFF_SG = SLOT2 + 80 * MiB, OFF_X1H = 436 * MiB  , OFF_Q = SLOT2, OFF_SG2 = SLOT2 + 96 * MiB;
constexpr size_t OFF_X2 = SLOT2;
constexpr size_t OFF_TAGS = 432 * MiB;
constexpr size_t OFF_KF = SLOT3  , OFF_KR = SLOT3 + 64 * MiB  , OFF_VT = SLOT3 + 96 * MiB;

struct Params {
  const float *x, *norm_a, *w_in_a, *conv_w, *conv_b, *w_rg, *b_rg, *w_ig, *b_ig, *lam, *w_out_a;
  const float *norm_kv, *w_dkv, *kv_norm, *w_uk, *w_uv, *norm_b, *w_in_b, *q_norm, *w_uq, *w_out_b, *final_norm;
  float* out;
  unsigned char* ws;
};

DI int crow(int i, int h) { return (i & 3) + 8 * (i >> 2) + 4 * h; }
DI constexpr int crow0(int i) { return (i & 3) + 8 * (i >> 2); }
DI float fexp2(float x) { return __builtin_amdgcn_exp2f(x); }
DI float frcp(float x) { return __builtin_amdgcn_rcpf(x); }
DI float silu_f(float v) { return v * frcp(1.f + fexp2(-1.44269504f * v)); }
DI float wave_sum(float v) {
#pragma unroll
  for (int o = 32; o; o >>= 1) v += __shfl_xor(v, o);
  return v;
}
DI float half_sum32(float v) {
#pragma unroll
  for (int o = 16; o; o >>= 1) v += __shfl_xor(v, o);
  return v;
}
DI int ptid() { int t = __builtin_amdgcn_workitem_id_x(); asm volatile("" : "+v"(t)); return t; }
DI int vblock() { return (blockIdx.x & 7) * (gridDim.x >> 3) + (blockIdx.x >> 3); }
DI int round_item(int k, int n) {
  const int G = gridDim.x, base = k * G;
  if (base + G <= n) return base + vblock();
  const int t = base + (int)blockIdx.x;
  return t < n ? t : -1;
}

DI void transpose_tile(const float* __restrict__ src, int ld, int n_off, h16* __restrict__ dst, int dst_ld, int row_off,
                       const float* __restrict__ gain, int tn, int tk, float* lds) {
  const int tid = ptid();
  const int k0 = tk * 64, n0 = tn * 64;
#pragma unroll
  for (int i = 0; i < 4; i++) {
    const int idx = tid + 256 * i, kk = idx >> 4, n4 = idx & 15;
    const float4 v = *(const float4*)(src + (size_t)(k0 + kk) * ld + n_off + n0 + n4 * 4);
    const float g = gain ? gain[k0 + kk] : 1.f;
    float* d = lds + kk * 65 + n4 * 4;
    d[0] = v.x * g; d[1] = v.y * g; d[2] = v.z * g; d[3] = v.w * g;
  }
  __syncthreads();
#pragma unroll
  for (int i = 0; i < 2; i++) {
    const int idx = tid + 256 * i, nn = idx >> 3, kc = idx & 7;
    h16x8 o;
#pragma unroll
    for (int j = 0; j < 8; j++) o[j] = (h16)lds[(kc * 8 + j) * 65 + nn];
    *(h16x8*)(dst + (size_t)(row_off + n0 + nn) * dst_ld + k0 + kc * 8) = o;
  }
  __syncthreads();
}

DI void phase0(const Params& p, unsigned char* smem) {
  float* lds = (float*)smem;
  unsigned char* ws = p.ws;
  const int tid = ptid(), lane = tid & 63;
  for (int t = blockIdx.x; t < 2000; t += gridDim.x) {
    int u = t;
    if (u < 640) { transpose_tile(p.w_in_a, 2560, 0, (h16*)(ws + OFF_W1T), LD1K, 0, nullptr, u % 40, u / 40, lds); continue; }
    u -= 640;
    if (u < 80) {
      const int which = u / 40, n = (u % 40) >> 2, tn = u & 1, tk = (u >> 1) & 1;
      transpose_tile((which ? p.w_ig : p.w_rg) + n * 16384, 128, 0, (h16*)(ws + (which ? OFF_WIG : OFF_WRG)), 128, n * 128, nullptr, tn, tk, lds);
      continue;
    }
    u -= 80;
    if (u < 320) { transpose_tile(p.w_out_a, 1024, 0, (h16*)(ws + OFF_WOA), LDY, 0, nullptr, u % 16, u / 16, lds); continue; }
    u -= 320;
    if (u < 64) { transpose_tile(p.w_dkv, 320, 0, (h16*)(ws + OFF_W4T), LD1K, 0, p.norm_kv, u % 4, u / 4, lds); continue; }
    u -= 64;
    if (u < 96) { transpose_tile(p.w_in_b, 1408, 0, (h16*)(ws + OFF_W4T), LD1K, 256, p.norm_b, u % 6, u / 6, lds); continue; }
    u -= 96;
    if (u < 256) { transpose_tile(p.w_in_b, 1408, 384, (h16*)(ws + OFF_W4T), LD1K, 640, p.norm_b, u % 16, u / 16, lds); continue; }
    u -= 256;
    if (u < 16) { transpose_tile(p.w_dkv, 320, 256, (h16*)(ws + OFF_W4T), LD1K, 1664, p.norm_kv, 0, u, lds); continue; }
    u -= 16;
    if (u < 64) { transpose_tile(p.w_uk, 1024, 0, (h16*)(ws + OFF_W5KV), LDKV, 0, p.kv_norm, u % 16, u / 16, lds); continue; }
    u -= 64;
    if (u < 64) { transpose_tile(p.w_uv, 1024, 0, (h16*)(ws + OFF_W5KV), LDKV, 1024, p.kv_norm, u % 16, u / 16, lds); continue; }
    u -= 64;
    if (u < 144) { transpose_tile(p.w_uq, 1536, 0, (h16*)(ws + OFF_W5Q), 384, 0, p.q_norm, u % 24, u / 24, lds); continue; }
    u -= 144;
    transpose_tile(p.w_out_b, 1024, 0, (h16*)(ws + OFF_WOB), LD1K, 0, nullptr, u % 16, u / 16, lds);
  }
  {
    u32x4* tz = (u32x4*)(ws + OFF_TAGS);
    for (int e = blockIdx.x * 256 + tid; e < M_TOK * 16 * 8 / 16; e += gridDim.x * 256) tz[e] = (u32x4){0u, 0u, 0u, 0u};
  }
  {
    h16* z = (h16*)(ws + OFF_W4T) + (size_t)1728 * LD1K;
    for (int e = blockIdx.x * 256 + tid; e < 64 * LD1K; e += gridDim.x * 256) z[e] = (h16)0.f;
  }
  {
    float* ct = (float*)(ws + OFF_COS);
    float* st = (float*)(ws + OFF_SIN);
    for (int e = blockIdx.x * 256 + tid; e < SEQ * 32; e += gridDim.x * 256) {
      const int pos = e >> 5, i = e & 31;
      const float inv = powf(10000.f, -(float)(2 * i) / 64.f);
      const float ang = (float)pos * inv;
      const double a = (double)ang;
      const double k = rint(a * 0.15915494309189535);
      const float rr = (float)(a - k * 6.283185307179586);
      ct[e] = cosf(rr);
      st[e] = sinf(rr);
    }
  }
  {
    h16* h0 = (h16*)(ws + OFF_H0);
    const int nwv = gridDim.x * 4;
    const int rpw = (((M_TOK + nwv - 1) / nwv) + 3) & ~3;
    const int rbase = (blockIdx.x * 4 + (tid >> 6)) * rpw;
    float4 g[4];
#pragma unroll
    for (int i = 0; i < 4; i++) g[i] = ((const float4*)p.norm_a)[lane + 64 * i];
    for (int k = 0; k < rpw && rbase + k < M_TOK; k += 4) {
      float4 v[4][4];
#pragma unroll
      for (int u = 0; u < 4; u++) {
        const float4* xr = (const float4*)(p.x + (size_t)(rbase + k + u) * 1024);
#pragma unroll
        for (int i = 0; i < 4; i++) v[u][i] = xr[lane + 64 * i];
      }
#pragma unroll
      for (int u = 0; u < 4; u++) {
        float ss = 0.f;
#pragma unroll
        for (int i = 0; i < 4; i++) ss += v[u][i].x * v[u][i].x + v[u][i].y * v[u][i].y + v[u][i].z * v[u][i].z + v[u][i].w * v[u][i].w;
        ss = wave_sum(ss);
        const float rinv = rsqrtf(ss * (1.f / 1024.f) + 1e-6f);
#pragma unroll
        for (int i = 0; i < 4; i++) {
          h16x4 o;
          o[0] = (h16)(v[u][i].x * rinv * g[i].x);
          o[1] = (h16)(v[u][i].y * rinv * g[i].y);
          o[2] = (h16)(v[u][i].z * rinv * g[i].z);
          o[3] = (h16)(v[u][i].w * rinv * g[i].w);
          *(h16x4*)(h0 + (size_t)(rbase + k + u) * LD1K + (lane + 64 * i) * 4) = o;
        }
      }
    }
  }
}

constexpr int LROW = 144;
constexpr int MI = 4;
constexpr int GEMM_LDS = 384 * LROW;
template <bool SWAP, bool PIN = false>
DI void gemm_mainloop(const h16* __restrict__ A, int lda, const h16* __restrict__ Bt, int ldb, int K, int m0, int n0,
                      unsigned char* smem, f32x16 (&acc)[MI][2], int kstart = 0) {
  const int tid = ptid(), lane = tid & 63, w = tid >> 6;
  const int r = lane & 31, h = lane >> 5;
  const int wm = w >> 1, wn = w & 1;
  const int seg = tid & 7, lrow = tid >> 3;
  const unsigned char* Ab = (const unsigned char*)(A + (size_t)m0 * lda);
  const unsigned char* Bb = (const unsigned char*)(Bt + (size_t)n0 * ldb);
  const unsigned offa0 = (unsigned)(lrow * lda + seg * 8) * 2u, offb0 = (unsigned)(lrow * ldb + seg * 8) * 2u;
  int kcur = kstart;
  unsigned offa = offa0 + (unsigned)kcur * 128u, offb = offb0 + (unsigned)kcur * 128u;
  u32x4 st[12];
#pragma unroll
  for (int i = 0; i < 8; i++) st[i] = *(const u32x4*)(Ab + (size_t)i * 64 * lda + offa);
#pragma unroll
  for (int i = 0; i < 4; i++) st[8 + i] = *(const u32x4*)(Bb + (size_t)i * 64 * ldb + offb);
#pragma unroll
  for (int mi = 0; mi < MI; mi++)
#pragma unroll
    for (int ni = 0; ni < 2; ni++)
#pragma unroll
      for (int i = 0; i < 16; i++) acc[mi][ni][i] = 0.f;
  const int nk = K >> 6;
  unsigned char* wA = smem + lrow * LROW + seg * 16;
  const unsigned char* rA = smem + (wm * 128 + r) * LROW + h * 16;
  const unsigned char* rB = smem + (256 + wn * 64 + r) * LROW + h * 16;
  for (int kt = 0; kt < nk; kt++) {
#pragma unroll
    for (int i = 0; i < 12; i++) *(u32x4*)(wA + i * 32 * LROW) = st[i];
    __syncthreads();
    if (kt + 1 < nk) {
      kcur = (kcur + 1 == nk) ? 0 : kcur + 1;
      offa = offa0 + (unsigned)kcur * 128u;
      offb = offb0 + (unsigned)kcur * 128u;
#pragma unroll
      for (int i = 0; i < 8; i++) st[i] = *(const u32x4*)(Ab + (size_t)i * 64 * lda + offa);
#pragma unroll
      for (int i = 0; i < 4; i++) st[8 + i] = *(const u32x4*)(Bb + (size_t)i * 64 * ldb + offb);
    }
    if (PIN) __builtin_amdgcn_sched_barrier(0);
#pragma unroll
    for (int ks = 0; ks < 4; ks++) {
      h16x8 af[MI], bf[2];
#pragma unroll
      for (int mi = 0; mi < MI; mi++) af[mi] = *(const h16x8*)(rA + mi * 32 * LROW + ks * 32);
      bf[0] = *(const h16x8*)(rB + ks * 32);
      bf[1] = *(const h16x8*)(rB + 32 * LROW + ks * 32);
#pragma unroll
      for (int mi = 0; mi < MI; mi++)
#pragma unroll
        for (int ni = 0; ni < 2; ni++)
          acc[mi][ni] = SWAP ? MFMA(bf[ni], af[mi], acc[mi][ni]) : MFMA(af[mi], bf[ni], acc[mi][ni]);
    }
    __syncthreads();
  }
}


constexpr int STG_ROW = 144;
constexpr int STG_WAVE = 64 * STG_ROW;
DI void stage_put(unsigned char* wl, int r, int h, int ni, int gi, h16x4 o) {
  *(h16x4*)(wl + r * STG_ROW + (ni * 32 + 8 * gi + 4 * h) * 2) = o;
}
DI void stage_fence() {
  __builtin_amdgcn_fence(__ATOMIC_ACQ_REL, "wavefront");
  __builtin_amdgcn_wave_barrier();
}
DI void stage_flush(const unsigned char* wl, int lane, h16* grow0, size_t ld) {
  stage_fence();
#pragma unroll
  for (int k = 0; k < 4; k++) {
    const int idx = lane + 64 * k, row = idx >> 3, seg = idx & 7;
    const u32x4 v = *(const u32x4*)(wl + row * STG_ROW + seg * 16);
    *(u32x4*)(grow0 + (size_t)row * ld + seg * 8) = v;
  }
  stage_fence();
}

DI void phase1(const Params& p, unsigned char* smem) {
  unsigned char* ws = p.ws;
  const h16* A = (const h16*)(ws + OFF_H0);
  const h16* Bt = (const h16*)(ws + OFF_W1T);
  h16* xb = (h16*)(ws + OFF_XB);
  h16* sg = (h16*)(ws + OFF_SG);
  const int lane = ptid() & 63, w = ptid() >> 6, r = lane & 31, h = lane >> 5, wm = w >> 1, wn = w & 1;
  for (int t = vblock(); t < 128 * 20; t += gridDim.x) {
    const int m0 = (t / 20) * 256, n0 = (t % 20) * 128;
    f32x16 acc[MI][2];
    const int nb = n0 + wn * 64;
    if (n0 >= 1280) {
      gemm_mainloop<false>(A, LD1K, Bt, LD1K, 1024, m0, n0, smem, acc, (t * 5) & 15);
#pragma unroll
      for (int mi = 0; mi < MI; mi++)
#pragma unroll
        for (int ni = 0; ni < 2; ni++) {
          const int tb = (m0 + wm * 128 + mi * 32) >> 5, cb = (nb - 1280 + ni * 32) >> 5;
          h16x8 v0, v1;
#pragma unroll
          for (int i = 0; i < 8; i++) {
            v0[i] = (h16)silu_f(acc[mi][ni][i]);
            v1[i] = (h16)silu_f(acc[mi][ni][8 + i]);
          }
          h16* d = sg + (((size_t)tb * 40 + cb) * 64 + lane) * 16;
          *(h16x8*)d = v0;
          *(h16x8*)(d + 8) = v1;
        }
    } else {
      gemm_mainloop<true>(A, LD1K, Bt, LD1K, 1024, m0, n0, smem, acc, (t * 5) & 15);
      unsigned char* wl = smem + w * STG_WAVE;
#pragma unroll
      for (int mi = 0; mi < MI; mi++) {
#pragma unroll
        for (int ni = 0; ni < 2; ni++)
#pragma unroll
          for (int gi = 0; gi < 4; gi++) {
            h16x4 o;
#pragma unroll
            for (int j = 0; j < 4; j++) o[j] = (h16)acc[mi][ni][gi * 4 + j];
            stage_put(wl, r, h, ni, gi, o);
          }
        stage_flush(wl, lane, xb + (size_t)(m0 + wm * 128 + mi * 32) * 1280 + nb, 1280);
      }
    }
    __syncthreads();
  }
}

DI void phase2(const Params& p, unsigned char* smem) {
  unsigned char* ws = p.ws;
  const h16* xb = (const h16*)(ws + OFF_XB);
  const h16* sg = (const h16*)(ws + OFF_SG);
  h16* y = (h16*)(ws + OFF_Y);
  const h16* Wrg = (const h16*)(ws + OFF_WRG);
  const h16* Wig = (const h16*)(ws + OFF_WIG);
  h16* As = (h16*)smem;
  h16* cw_s = (h16*)(smem + 34816);
  h16* cb_s = (h16*)(smem + 36864);
  float* agg = (float*)(smem + 37376);
  h16* Ys = (h16*)(smem + 38400);
  const int tid = ptid(), lane = tid & 63, w = tid >> 6, r = lane & 31, h = lane >> 5;
  const float L2E = 1.44269504f;
  for (int rk = 0; rk * (int)gridDim.x < 640; rk++) {
    const int it = round_item(rk, 640);
    if (it < 0) break;
    const int b = it / 40, n = (it % 40) >> 2, q = it & 3;
    __syncthreads();
    if (tid < 128) {
      cb_s[tid] = (h16)p.conv_b[n * 128 + tid];
#pragma unroll
      for (int k = 0; k < 4; k++) cw_s[k * 128 + tid] = (h16)p.conv_w[k * 1280 + n * 128 + tid];
    }
    h16x8 brg[8], big[8];
    {
      const h16* wr = Wrg + (size_t)(n * 128 + q * 32 + r) * 128 + h * 8;
      const h16* wi = Wig + (size_t)(n * 128 + q * 32 + r) * 128 + h * 8;
#pragma unroll
      for (int ks = 0; ks < 8; ks++) {
        brg[ks] = *(const h16x8*)(wr + ks * 16);
        big[ks] = *(const h16x8*)(wi + ks * 16);
      }
    }
    const int ch = n * 128 + q * 32 + r;
    const float cbr = -L2E * p.b_rg[ch], cbi = -L2E * p.b_ig[ch];
    const float cch2 = -8.f * L2E * log1pf(expf(-p.lam[ch]));
    float hc = 0.f;
    const int cgp = tid & 15, rgp = tid >> 4;
    const h16* src = xb + ((size_t)(b * SEQ) + rgp * 8 - 3) * 1280 + n * 128 + cgp * 8;
    u32x4 xin[11];
#pragma unroll
    for (int j = 0; j < 11; j++) {
      if (rgp == 0 && j < 3) xin[j] = (u32x4){0u, 0u, 0u, 0u};
      else xin[j] = *(const u32x4*)(src + (ptrdiff_t)j * 1280);
    }
    __syncthreads();
    for (int c = 0; c < 16; c++) {
      {
        const h16x8 w0 = *(const h16x8*)(cw_s + 0 * 128 + cgp * 8), w1 = *(const h16x8*)(cw_s + 1 * 128 + cgp * 8);
        const h16x8 w2 = *(const h16x8*)(cw_s + 2 * 128 + cgp * 8), w3 = *(const h16x8*)(cw_s + 3 * 128 + cgp * 8);
        const h16x8 bb = *(const h16x8*)(cb_s + cgp * 8);
#pragma unroll
        for (int o = 0; o < 8; o++) {
          h16x8 a = w0 * __builtin_bit_cast(h16x8, xin[o]) + bb;
          a = w1 * __builtin_bit_cast(h16x8, xin[o + 1]) + a;
          a = w2 * __builtin_bit_cast(h16x8, xin[o + 2]) + a;
          a = w3 * __builtin_bit_cast(h16x8, xin[o + 3]) + a;
          *(h16x8*)(As + (rgp * 8 + o) * 136 + cgp * 8) = a;
        }
      }
      __syncthreads();
      if (c + 1 < 16) {
        const h16* s2 = src + (size_t)(c + 1) * 128 * 1280;
#pragma unroll
        for (int j = 0; j < 11; j++) xin[j] = *(const u32x4*)(s2 + (ptrdiff_t)j * 1280);
      }
      __builtin_amdgcn_sched_barrier(0);
      const int tb = (b * SEQ + c * 128 + w * 32) >> 5, cbk = n * 4 + q;
      const h16* sgp = sg + (((size_t)tb * 40 + cbk) * 64 + lane) * 16;
      const h16x8 sg0 = *(const h16x8*)sgp, sg1 = *(const h16x8*)(sgp + 8);
      f32x16 ar, ai;
#pragma unroll
      for (int i = 0; i < 16; i++) { ar[i] = 0.f; ai[i] = 0.f; }
      {
        const unsigned char* rA = (const unsigned char*)As + (w * 32 + r) * 272 + h * 16;
#pragma unroll
        for (int ks = 0; ks < 8; ks++) {
          const h16x8 a = *(const h16x8*)(rA + ks * 32);
          ar = MFMA(a, brg[ks], ar);
          ai = MFMA(a, big[ks], ai);
        }
      }
      float P[16], H[16], SA[4], SB[4];
#pragma unroll
      for (int gi = 0; gi < 4; gi++) {
        float pp = 1.f, hh = 0.f;
#pragma unroll
        for (int j = 0; j < 4; j++) {
          const int i = gi * 4 + j;
          const int tok = w * 32 + 8 * gi + 4 * h + j;
          const float xc = (float)As[tok * 136 + q * 32 + r];
          const float a1 = fminf(fmaf(ar[i], -L2E, cbr), 60.f), a2 = fminf(fmaf(ai[i], -L2E, cbi), 60.f);
          const float t1 = 1.f + fexp2(a1), t2 = 1.f + fexp2(a2);
          const float inv = frcp(t1 * t2);
          const float rs = t2 * inv, is = t1 * inv;
          const float a = fexp2(cch2 * rs);
          const float om = fmaf(-a, a, 1.f);
          const float bt = __builtin_amdgcn_sqrtf(om) * is * xc;
          hh = a * hh + bt;
          pp = a * pp;
          P[i] = pp;
          H[i] = hh;
        }
        SA[gi] = pp;
        SB[gi] = hh;
      }
      float CA = 1.f, CB = 0.f, inA[4], inB[4];
#pragma unroll
      for (int gi = 0; gi < 4; gi++) {
        const float oa = __shfl_xor(SA[gi], 32), ob = __shfl_xor(SB[gi], 32);
        const float a0 = h ? oa : SA[gi], b0 = h ? ob : SB[gi];
        const float a1 = h ? SA[gi] : oa, b1 = h ? SB[gi] : ob;
        const float ca0 = CA, cb0 = CB;
        CB = a0 * CB + b0;
        CA = a0 * CA;
        inA[gi] = h ? CA : ca0;
        inB[gi] = h ? CB : cb0;
        CB = a1 * CB + b1;
        CA = a1 * CA;
      }
      if (h == 0) {
        agg[(w * 32 + r) * 2] = CA;
        agg[(w * 32 + r) * 2 + 1] = CB;
      }
      __syncthreads();
      float hin = hc, hrun = hc;
#pragma unroll
      for (int w2 = 0; w2 < 4; w2++) {
        const float a = agg[(w2 * 32 + r) * 2], bb = agg[(w2 * 32 + r) * 2 + 1];
        if (w2 == w) hin = hrun;
        hrun = a * hrun + bb;
      }
      hc = hrun;
#pragma unroll
      for (int gi = 0; gi < 4; gi++) {
        const float hs = inA[gi] * hin + inB[gi];
#pragma unroll
        for (int j = 0; j < 4; j++) {
          const int i = gi * 4 + j;
          const int tok = w * 32 + 8 * gi + 4 * h + j;
          const float hv = H[i] + P[i] * hs;
          const float g = (float)(i < 8 ? sg0[i & 7] : sg1[i & 7]);
          Ys[tok * 40 + r] = (h16)(hv * g);
        }
      }
      __syncthreads();
#pragma unroll
      for (int k = 0; k < 2; k++) {
        const int idx = tid + 256 * k, row = idx >> 2, seg = idx & 3;
        *(u32x4*)(y + ((size_t)(b * SEQ + c * 128 + row)) * LDY + n * 128 + q * 32 + seg * 8) = *(const u32x4*)(Ys + row * 40 + seg * 8);
      }
    }
  }
}

DI void phase_res_gemm(const h16* __restrict__ A, int ld, int K, const h16* __restrict__ Bt, const float* __restrict__ res, float* __restrict__ outp, h16* __restrict__ outh, float* __restrict__ ssq,
                       unsigned char* smem) {
  const int lane = ptid() & 63, w = ptid() >> 6, r = lane & 31, h = lane >> 5, wm = w >> 1, wn = w & 1;
  for (int t = vblock(); t < 128 * 8; t += gridDim.x) {
    const int m0 = (t >> 3) * 256, n0 = (t & 7) * 128;
    f32x16 acc[MI][2];
    gemm_mainloop<true>(A, ld, Bt, ld, K, m0, n0, smem, acc);
    const int nb = n0 + wn * 64;
    unsigned char* wl = smem + w * STG_WAVE;
#pragma unroll
    for (int mi = 0; mi < MI; mi++) {
      const int rowb = m0 + wm * 128 + mi * 32;
      const int row = rowb + r;
#pragma unroll
      for (int k = 0; k < 8; k++) {
        const int idx = lane + 64 * k, rr = idx >> 4, sg4 = idx & 15;
        *(float4*)(wl + rr * 272 + sg4 * 16) = *(const float4*)(res + (size_t)(rowb + rr) * 1024 + nb + sg4 * 4);
      }
      stage_fence();
      float sq = 0.f;
      h16x4 ov[2][4];
#pragma unroll
      for (int ni = 0; ni < 2; ni++)
#pragma unroll
        for (int gi = 0; gi < 4; gi++) {
          float4 v = *(const float4*)(wl + r * 272 + (ni * 32 + 8 * gi + 4 * h) * 4);
          v.x += acc[mi][ni][gi * 4 + 0];
          v.y += acc[mi][ni][gi * 4 + 1];
          v.z += acc[mi][ni][gi * 4 + 2];
          v.w += acc[mi][ni][gi * 4 + 3];
          if (outp) *(float4*)(outp + (size_t)row * 1024 + nb + 4 * h + ni * 32 + 8 * gi) = v;
          ov[ni][gi][0] = (h16)v.x; ov[ni][gi][1] = (h16)v.y; ov[ni][gi][2] = (h16)v.z; ov[ni][gi][3] = (h16)v.w;
          sq += v.x * v.x + v.y * v.y + v.z * v.z + v.w * v.w;
        }
      stage_fence();
#pragma unroll
      for (int ni = 0; ni < 2; ni++)
#pragma unroll
        for (int gi = 0; gi < 4; gi++) stage_put(wl, r, h, ni, gi, ov[ni][gi]);
      stage_flush(wl, lane, outh + (size_t)rowb * LD1K + nb, LD1K);
      sq += __shfl_xor(sq, 32);
      if (h == 0) ssq[(size_t)row * 16 + (nb >> 6)] = sq;
    }
    __syncthreads();
  }
}

DI void phase_final(const Params& p, unsigned char* smem) {
  unsigned char* ws = p.ws;
  const h16* A = (const h16*)(ws + OFF_Y2);
  const h16* Bt = (const h16*)(ws + OFF_WOB);
  const h16* __restrict__ res = (const h16*)(ws + OFF_X1H);
  unsigned long long* tags = (unsigned long long*)(ws + OFF_TAGS);
  const int lane = ptid() & 63, w = ptid() >> 6, r = lane & 31, h = lane >> 5, wm = w >> 1, wn = w & 1;
  for (int t = vblock(); t < 128 * 8; t += gridDim.x) {
    const int m0 = (t >> 3) * 256, n0 = (t & 7) * 128;
    f32x16 acc[MI][2];
    gemm_mainloop<true>(A, LD1K, Bt, LD1K, 1024, m0, n0, smem, acc);
    const int nb = n0 + wn * 64;
#pragma unroll
    for (int mi = 0; mi < MI; mi++) {
      const int row = m0 + wm * 128 + mi * 32 + r;
      float sq = 0.f;
      unsigned char* wlr = smem + w * STG_WAVE;
      {
        const h16* rsrc = res + (size_t)(m0 + wm * 128 + mi * 32) * LD1K + nb;
#pragma unroll
        for (int k = 0; k < 4; k++) {
          const int idx = lane + 64 * k, rr = idx >> 3, sg8 = idx & 7;
          *(u32x4*)(wlr + rr * STG_ROW + sg8 * 16) = *(const u32x4*)(rsrc + (size_t)rr * LD1K + sg8 * 8);
        }
        stage_fence();
      }
#pragma unroll
      for (int ni = 0; ni < 2; ni++)
#pragma unroll
        for (int gi = 0; gi < 4; gi++) {
          const h16x4 v = *(const h16x4*)(wlr + r * STG_ROW + (ni * 32 + 8 * gi + 4 * h) * 2);
#pragma unroll
          for (int j = 0; j < 4; j++) acc[mi][ni][gi * 4 + j] += (float)v[j];
#pragma unroll
          for (int j = 0; j < 4; j++) sq += acc[mi][ni][gi * 4 + j] * acc[mi][ni][gi * 4 + j];
        }
      stage_fence();
      sq += __shfl_xor(sq, 32);
      if (h == 0) {
        const unsigned long long pk = (unsigned long long)__float_as_uint(sq) | (1ull << 32);
        __hip_atomic_store(tags + (size_t)row * 16 + (nb >> 6), pk, __ATOMIC_RELAXED, __HIP_MEMORY_SCOPE_AGENT);
      }
    }
#pragma unroll
    for (int mi = 0; mi < MI; mi++) {
      const int row = m0 + wm * 128 + mi * 32 + r;
      float tot = 0.f;
#pragma unroll
      for (int k = 0; k < 8; k++) {
        unsigned long long* tp = tags + (size_t)row * 16 + 8 * h + k;
        unsigned long long v = __hip_atomic_load(tp, __ATOMIC_RELAXED, __HIP_MEMORY_SCOPE_AGENT);
        unsigned spin = 0;
        while ((unsigned)(v >> 32) != 1u && spin < (1u << 22)) {
          __builtin_amdgcn_s_sleep(1);
          v = __hip_atomic_load(tp, __ATOMIC_RELAXED, __HIP_MEMORY_SCOPE_AGENT);
          ++spin;
        }
        tot += __uint_as_float((unsigned)v);
      }
      tot += __shfl_xor(tot, 32);
      const float rinv = rsqrtf(tot * (1.f / 1024.f) + 1e-6f);
      unsigned char* wl = smem + w * STG_WAVE;
#pragma unroll
      for (int ni = 0; ni < 2; ni++)
#pragma unroll
        for (int gi = 0; gi < 4; gi++) {
          const float4 g = *(const float4*)(p.final_norm + nb + 4 * h + ni * 32 + 8 * gi);
          float4 o;
          o.x = acc[mi][ni][gi * 4 + 0] * rinv * g.x;
          o.y = acc[mi][ni][gi * 4 + 1] * rinv * g.y;
          o.z = acc[mi][ni][gi * 4 + 2] * rinv * g.z;
          o.w = acc[mi][ni][gi * 4 + 3] * rinv * g.w;
          *(float4*)(wl + r * 272 + (ni * 32 + 8 * gi + 4 * h) * 4) = o;
        }
      stage_fence();
      const int rowb = m0 + wm * 128 + mi * 32;
#pragma unroll
      for (int k = 0; k < 8; k++) {
        const int idx = lane + 64 * k, rr = idx >> 4, sg4 = idx & 15;
        *(float4*)(p.out + (size_t)(rowb + rr) * 1024 + nb + sg4 * 4) = *(const float4*)(wl + rr * 272 + sg4 * 16);
      }
      stage_fence();
    }
    __syncthreads();
  }
}

DI void phase4(const Params& p, unsigned char* smem) {
  unsigned char* ws = p.ws;
  const h16* A = (const h16*)(ws + OFF_X1H);
  const h16* Bt = (const h16*)(ws + OFF_W4T);
  const float* ssq = (const float*)(ws + OFF_SSQX1);
  h16* ckv = (h16*)(ws + OFF_CKV);
  h16* cq = (h16*)(ws + OFF_CQ);
  h16* sg2 = (h16*)(ws + OFF_SG2);
  h16* Kf = (h16*)(ws + OFF_KF);
  float* ssqkv = (float*)(ws + OFF_SSQKV);
  float* ssqq = (float*)(ws + OFF_SSQQ);
  const float* ct = (const float*)(ws + OFF_COS);
  const float* st = (const float*)(ws + OFF_SIN);
  float* rinv_s = (float*)(smem + GEMM_LDS);
  const int tid = ptid(), lane = tid & 63, w = tid >> 6, r = lane & 31, h = lane >> 5, wm = w >> 1, wn = w & 1;
  for (int base = 0; base < 128 * 14; base += gridDim.x) {
    const int t = base + ((base + (int)gridDim.x <= 128 * 14) ? vblock() : (int)blockIdx.x);
    if (t >= 128 * 14) break;
    const int m0 = (t / 14) * 256, n0 = (t % 14) * 128;
    {
      const float4* sp = (const float4*)(ssq + (size_t)(m0 + tid) * 16);
      float s = 0.f;
#pragma unroll
      for (int i = 0; i < 4; i++) { const float4 v = sp[i]; s += v.x + v.y + v.z + v.w; }
      rinv_s[tid] = rsqrtf(s * (1.f / 1024.f) + 1e-6f);
    }
    f32x16 acc[MI][2];
    gemm_mainloop<true>(A, LD1K, Bt, LD1K, 1024, m0, n0, smem, acc);
    const int nb = n0 + wn * 64;
    const int sub = nb >> 6;
    const int lr0 = wm * 128 + r;
    const int row0 = m0 + lr0;
    unsigned char* wl = smem + w * STG_WAVE;
    const int rowt = m0 + wm * 128;
    if (sub < 10) {
      const bool iskv = sub < 4;
      h16* gb = iskv ? ckv + (size_t)rowt * LDKV + nb : cq + (size_t)rowt * 384 + (nb - 256);
      const int ld = iskv ? LDKV : 384;
      float* sqb = iskv ? ssqkv + (size_t)row0 * 4 + sub : ssqq + (size_t)row0 * 8 + (sub - 4);
      const int sld = iskv ? 4 : 8;
#pragma unroll
      for (int mi = 0; mi < MI; mi++) {
        const float ri = rinv_s[lr0 + mi * 32];
        float sq = 0.f;
#pragma unroll
        for (int ni = 0; ni < 2; ni++)
#pragma unroll
          for (int gi = 0; gi < 4; gi++) {
            h16x4 o;
#pragma unroll
            for (int j = 0; j < 4; j++) {
              const float v = acc[mi][ni][gi * 4 + j] * ri;
              o[j] = (h16)v;
              sq += v * v;
            }
            stage_put(wl, r, h, ni, gi, o);
          }
        stage_flush(wl, lane, gb + (size_t)mi * 32 * ld, ld);
        sq += __shfl_xor(sq, 32);
        if (h == 0) sqb[mi * 32 * sld] = sq;
      }
    } else if (sub < 26) {
      h16* gb = sg2 + (size_t)rowt * 1024 + (nb - 640);
#pragma unroll
      for (int mi = 0; mi < MI; mi++) {
        const float ri = rinv_s[lr0 + mi * 32];
#pragma unroll
        for (int ni = 0; ni < 2; ni++)
#pragma unroll
          for (int gi = 0; gi < 4; gi++) {
            h16x4 o;
#pragma unroll
            for (int j = 0; j < 4; j++) o[j] = (h16)silu_f(acc[mi][ni][gi * 4 + j] * ri);
            stage_put(wl, r, h, ni, gi, o);
          }
        stage_flush(wl, lane, gb + (size_t)mi * 32 * 1024, 1024);
      }
    } else if (sub == 26) {
      const int b = m0 >> 11, s0 = (m0 & 2047) + lr0;
#pragma unroll
      for (int mi = 0; mi < MI; mi++) {
        const float ri = rinv_s[lr0 + mi * 32];
        const int s = s0 + mi * 32;
#pragma unroll
        for (int gi = 0; gi < 4; gi++) {
          const int j0 = 8 * gi + 4 * h;
          const float4 c = *(const float4*)(ct + s * 32 + j0);
          const float4 sn = *(const float4*)(st + s * 32 + j0);
          const float cc[4] = {c.x, c.y, c.z, c.w}, ss[4] = {sn.x, sn.y, sn.z, sn.w};
          h16x4 o1, o2;
#pragma unroll
          for (int j = 0; j < 4; j++) {
            const float x1 = acc[mi][0][gi * 4 + j] * ri, x2 = acc[mi][1][gi * 4 + j] * ri;
            o1[j] = (h16)(x1 * cc[j] - x2 * ss[j]);
            o2[j] = (h16)(x2 * cc[j] + x1 * ss[j]);
          }
          stage_put(wl, r, h, 0, gi, o1);
          stage_put(wl, r, h, 1, gi, o2);
        }
        stage_flush(wl, lane, (h16*)(ws + OFF_KR) + (size_t)(m0 + wm * 128 + mi * 32) * 64, 64);
      }
    }
    __syncthreads();
  }
}

template <bool ISQ>
DI void phase5_part(const Params& p, unsigned char* smem) {
  unsigned char* ws = p.ws;
  const h16* ckv = (const h16*)(ws + OFF_CKV);
  const h16* cq = (const h16*)(ws + OFF_CQ);
  const h16* Wkv = (const h16*)(ws + OFF_W5KV);
  const h16* Wq = (const h16*)(ws + OFF_W5Q);
  const float* ssqkv = (const float*)(ws + OFF_SSQKV);
  const float* ssqq = (const float*)(ws + OFF_SSQQ);
  h16* Kf = (h16*)(ws + OFF_KF);
  h16* Vt = (h16*)(ws + OFF_VT);
  h16* Q = (h16*)(ws + OFF_Q);
  const float* ct = (const float*)(ws + OFF_COS);
  const float* st = (const float*)(ws + OFF_SIN);
  float* rinv_s = (float*)(smem + GEMM_LDS);
  const int tid = ptid(), lane = tid & 63, w = tid >> 6, r = lane & 31, h = lane >> 5, wm = w >> 1, wn = w & 1;
  const float qscale = 0.07216878364870322f * 1.4426950408889634f;
  constexpr int NTT = ISQ ? 12 : 16;
  for (int t = vblock(); t < 128 * NTT; t += gridDim.x) {
    const int mt = t / NTT, nt = (t % NTT) + (ISQ ? 16 : 0);
    const int m0 = mt * 256;
    const int bb = m0 >> 11;
    const int lr0 = wm * 128 + 4 * h;
    const int s0 = (m0 & 2047) + lr0;
    f32x16 acc[MI][2];
    constexpr bool is_q = ISQ;
    const bool is_v = (nt >= 8) && !is_q;
    {
      float rv;
      if (!is_q) {
        const float4 v = *(const float4*)(ssqkv + (size_t)(m0 + tid) * 4);
        rv = rsqrtf((v.x + v.y + v.z + v.w) * (1.f / 256.f) + 1e-6f);
      } else {
        const float4* sp = (const float4*)(ssqq + (size_t)(m0 + tid) * 8);
        const float4 v0 = sp[0], v1 = sp[1];
        rv = rsqrtf((v0.x + v0.y + v0.z + v0.w + v1.x + v1.y) * (1.f / 384.f) + 1e-6f) * qscale;
      }
      rinv_s[tid] = rv;
    }
    const h16* Ap = is_q ? cq : ckv;
    const h16* Bp = is_q ? Wq : Wkv;
    constexpr int Kd = is_q ? 384 : 256;
    constexpr int ldk = is_q ? 384 : LDKV;
    const int n0 = is_q ? (nt - 16) * 128 : nt * 128;
    gemm_mainloop<true, false>(Ap, ldk, Bp, ldk, Kd, m0, n0, smem, acc);
    const int lrw = wm * 128 + r;
    const int sw = (m0 & 2047) + lrw;
    unsigned char* wl = smem + w * STG_WAVE;
    const int st0 = (m0 & 2047) + wm * 128;
    if (!is_v) {
      const int sub = (n0 >> 6) + wn;
      const int hd = is_q ? sub / 3 : nt;
      const int part = is_q ? sub % 3 : wn;
      const int ldo = is_q ? 192 : 128;
      h16* gb = (is_q ? Q : Kf) + ((size_t)(bb * 8 + hd) * SEQ + st0) * ldo + part * 64;
      if (!is_q || part < 2) {
#pragma unroll
        for (int mi = 0; mi < MI; mi++) {
          const float ri = rinv_s[lrw + mi * 32];
#pragma unroll
          for (int ni = 0; ni < 2; ni++)
#pragma unroll
            for (int gi = 0; gi < 4; gi++) {
              h16x4 o;
#pragma unroll
              for (int j = 0; j < 4; j++) o[j] = (h16)(acc[mi][ni][gi * 4 + j] * ri);
              stage_put(wl, r, h, ni, gi, o);
            }
          stage_flush(wl, lane, gb + (size_t)mi * 32 * ldo, ldo);
        }
      } else {
#pragma unroll
        for (int mi = 0; mi < MI; mi++) {
          const float ri = rinv_s[lrw + mi * 32];
          const int s = sw + mi * 32;
#pragma unroll
          for (int gi = 0; gi < 4; gi++) {
            const int j0 = 8 * gi + 4 * h;
            const float4 c = *(const float4*)(ct + s * 32 + j0);
            const float4 sn = *(const float4*)(st + s * 32 + j0);
            const float cc[4] = {c.x, c.y, c.z, c.w}, ss[4] = {sn.x, sn.y, sn.z, sn.w};
            h16x4 o1, o2;
#pragma unroll
            for (int j = 0; j < 4; j++) {
              const float x1 = acc[mi][0][gi * 4 + j] * ri, x2 = acc[mi][1][gi * 4 + j] * ri;
              o1[j] = (h16)(x1 * cc[j] - x2 * ss[j]);
              o2[j] = (h16)(x2 * cc[j] + x1 * ss[j]);
            }
            stage_put(wl, r, h, 0, gi, o1);
            stage_put(wl, r, h, 1, gi, o2);
          }
          stage_flush(wl, lane, gb + (size_t)mi * 32 * 192, 192);
        }
      }
    } else {
#pragma unroll
      for (int mp = 0; mp < 2; mp++) {
#pragma unroll
        for (int m2 = 0; m2 < 2; m2++) {
          const int mi = mp * 2 + m2;
          const float ri = rinv_s[lrw + mi * 32];
          const int t = m2 * 32 + r;
          const int pos = (t & ~15) + 8 * ((t >> 2) & 1) + 4 * ((t >> 3) & 1) + (t & 3);
#pragma unroll
          for (int ni = 0; ni < 2; ni++)
#pragma unroll
            for (int i = 0; i < 16; i++)
              *(h16*)(wl + (ni * 32 + crow(i, h)) * STG_ROW + pos * 2) = (h16)(acc[mi][ni][i] * ri);
        }
        stage_fence();
        const int kt = (st0 + mp * 64) >> 6;
        h16* gv = Vt + (((size_t)(bb * 8 + (nt - 8)) * 32 + kt) * 128 + wn * 64) * 64;
#pragma unroll
        for (int k = 0; k < 8; k++) {
          const int idx = lane + 64 * k, row = idx >> 3, seg = idx & 7;
          *(u32x4*)(gv + row * 64 + seg * 8) = *(const u32x4*)(wl + row * STG_ROW + seg * 16);
        }
        stage_fence();
      }
    }
    __syncthreads();
  }
}

DI void phase5(const Params& p, unsigned char* smem) {
  phase5_part<false>(p, smem);
  phase5_part<true>(p, smem);
}

constexpr int KROW = 400;
constexpr int VROW = 144;
DI void phase6(const Params& p, unsigned char* smem) {
  unsigned char* ws = p.ws;
  const h16* Q = (const h16*)(ws + OFF_Q);
  const h16* Kf = (const h16*)(ws + OFF_KF);
  const h16* Vt = (const h16*)(ws + OFF_VT);
  const h16* sg2 = (const h16*)(ws + OFF_SG2);
  h16* y2 = (h16*)(ws + OFF_Y2);
  unsigned char* Ks = smem;
  unsigned char* Vs = smem + 64 * KROW;
  const int tid = ptid(), lane = tid & 63, w = tid >> 6, r = lane & 31, h = lane >> 5;
  for (int it2 = vblock() * 2; it2 < 2048; it2 += gridDim.x * 2)
  for (int sel = 0; sel < 2; sel++) {
    const int bh = it2 >> 4, xx = (it2 >> 1) & 7;
    const int qb = sel ? xx : 15 - xx;
    const int b = bh >> 3, hd = bh & 7;
    const int qrow = qb * 128 + w * 32 + r;
    h16x8 qf[12];
    {
      const h16* qp = Q + ((size_t)bh * SEQ + qrow) * 192 + h * 8;
#pragma unroll
      for (int ks = 0; ks < 12; ks++) qf[ks] = *(const h16x8*)(qp + ks * 16);
    }
    f32x16 O[4];
#pragma unroll
    for (int dt = 0; dt < 4; dt++)
#pragma unroll
      for (int i = 0; i < 16; i++) O[dt][i] = 0.f;
    float m = -INFINITY, l = 0.f;
    const int nkt = 2 * qb + 2;
    const h16* kbase = Kf + (size_t)bh * SEQ * 128;
    const h16* rbase = (const h16*)(ws + OFF_KR) + (size_t)b * SEQ * 64;
    const h16* vbase = Vt + (size_t)bh * 128 * SEQ;
    u32x4 kst[6], vst[4];
    const h16* kg = kbase + (size_t)(tid >> 4) * 128 + (tid & 15) * 8;
    const h16* rg = rbase + (size_t)(tid >> 3) * 64 + (tid & 7) * 8;
    const h16* vg = vbase + (size_t)(tid >> 3) * 64 + (tid & 7) * 8;
    unsigned char* kw = Ks + (tid >> 4) * KROW + (tid & 15) * 16;
    unsigned char* rw = Ks + (tid >> 3) * KROW + 256 + (tid & 7) * 16;
    unsigned char* vw = Vs + (tid >> 3) * VROW + (tid & 7) * 16;
#pragma unroll
    for (int i = 0; i < 4; i++) kst[i] = *(const u32x4*)(kg + i * 16 * 128);
#pragma unroll
    for (int i = 0; i < 2; i++) kst[4 + i] = *(const u32x4*)(rg + i * 32 * 64);
#pragma unroll
    for (int i = 0; i < 4; i++) vst[i] = *(const u32x4*)(vg + (size_t)i * 32 * 64);
    for (int kt = 0; kt < nkt; kt++) {
#pragma unroll
      for (int i = 0; i < 4; i++) *(u32x4*)(kw + i * 16 * KROW) = kst[i];
#pragma unroll
      for (int i = 0; i < 2; i++) *(u32x4*)(rw + i * 32 * KROW) = kst[4 + i];
#pragma unroll
      for (int i = 0; i < 4; i++) *(u32x4*)(vw + i * 32 * VROW) = vst[i];
      __syncthreads();
      if (kt + 1 < nkt) {
        kg += 64 * 128;
        rg += 64 * 64;
        vg += 8192;
#pragma unroll
        for (int i = 0; i < 4; i++) kst[i] = *(const u32x4*)(kg + i * 16 * 128);
#pragma unroll
        for (int i = 0; i < 2; i++) kst[4 + i] = *(const u32x4*)(rg + i * 32 * 64);
#pragma unroll
        for (int i = 0; i < 4; i++) vst[i] = *(const u32x4*)(vg + (size_t)i * 32 * 64);
      }
#pragma unroll
      for (int half = 0; half < 2; half++) {
        const int sb = (kt - (nkt - 2)) * 2 + half;
        if (sb > w) continue;
        f32x16 sc;
#pragma unroll
        for (int i = 0; i < 16; i++) sc[i] = 0.f;
        const unsigned char* kr = Ks + (half * 32 + r) * KROW + h * 16;
#pragma unroll
        for (int g = 0; g < 3; g++) {
          h16x8 kf[4];
#pragma unroll
          for (int j = 0; j < 4; j++) kf[j] = *(const h16x8*)(kr + (g * 4 + j) * 32);
#pragma unroll
          for (int j = 0; j < 4; j++) sc = MFMA(kf[j], qf[g * 4 + j], sc);
        }
        if (sb == w) {
#pragma unroll
          for (int i = 0; i < 16; i++)
            if (crow(i, h) > r) sc[i] = -INFINITY;
        }
        float mx = sc[0];
#pragma unroll
        for (int i = 1; i < 16; i++) mx = fmaxf(mx, sc[i]);
        mx = fmaxf(mx, __shfl_xor(mx, 32));
        const float mn = fmaxf(m, mx);
        if (__builtin_amdgcn_ballot_w64(mn > m) != 0ull) {
          const float alpha = fexp2(m - mn);
          m = mn;
          l *= alpha;
#pragma unroll
          for (int dt = 0; dt < 4; dt++)
#pragma unroll
            for (int i = 0; i < 16; i++) O[dt][i] *= alpha;
        }
        float ls = 0.f;
#pragma unroll
        for (int i = 0; i < 16; i++) {
          sc[i] = fexp2(sc[i] - m);
          ls += sc[i];
        }
        l += ls;
        h16x8 pf0, pf1;
#pragma unroll
        for (int jj = 0; jj < 8; jj++) {
          pf0[jj] = (h16)sc[jj];
          pf1[jj] = (h16)sc[8 + jj];
        }
        const unsigned char* vr = Vs + r * VROW + h * 16 + half * 64;
#pragma unroll
        for (int dp = 0; dp < 2; dp++) {
          h16x8 vf[4];
#pragma unroll
          for (int j = 0; j < 4; j++) vf[j] = *(const h16x8*)(vr + (dp * 2 + (j >> 1)) * 32 * VROW + (j & 1) * 32);
#pragma unroll
          for (int j = 0; j < 4; j++) O[dp * 2 + (j >> 1)] = MFMA(vf[j], (j & 1) ? pf1 : pf0, O[dp * 2 + (j >> 1)]);
        }
      }
      __syncthreads();
    }
    l += __shfl_xor(l, 32);
    const float inv = 1.f / l;
    {
      unsigned char* wl = smem + w * STG_WAVE;
      const int rowb = b * SEQ + qb * 128 + w * 32;
#pragma unroll
      for (int dp = 0; dp < 2; dp++) {
        const h16* gsrc = sg2 + (size_t)rowb * 1024 + hd * 128 + dp * 64;
#pragma unroll
        for (int k = 0; k < 4; k++) {
          const int idx = lane + 64 * k, rr = idx >> 3, sg8 = idx & 7;
          *(u32x4*)(wl + rr * STG_ROW + sg8 * 16) = *(const u32x4*)(gsrc + (size_t)rr * 1024 + sg8 * 8);
        }
        stage_fence();
        h16x4 ov[2][4];
#pragma unroll
        for (int ni = 0; ni < 2; ni++)
#pragma unroll
          for (int gi = 0; gi < 4; gi++) {
            const h16x4 gt = *(const h16x4*)(wl + r * STG_ROW + (ni * 32 + 8 * gi + 4 * h) * 2);
#pragma unroll
            for (int jj = 0; jj < 4; jj++) ov[ni][gi][jj] = (h16)(O[dp * 2 + ni][gi * 4 + jj] * inv * (float)gt[jj]);
          }
        stage_fence();
#pragma unroll
        for (int ni = 0; ni < 2; ni++)
#pragma unroll
          for (int gi = 0; gi < 4; gi++) stage_put(wl, r, h, ni, gi, ov[ni][gi]);
        stage_flush(wl, lane, y2 + (size_t)rowb * LD1K + hd * 128 + dp * 64, LD1K);
      }
    }
    __syncthreads();
  }
}

DI void phase8(const Params& p) {
  const float* ssq = (const float*)(p.ws + OFF_SSQO);
  const int tid = ptid(), lane = tid & 63;
  const int nw = gridDim.x * 4;
  for (int row = blockIdx.x * 4 + (tid >> 6); row < M_TOK; row += nw) {
    const float4* sp = (const float4*)(ssq + (size_t)row * 16);
    float s = 0.f;
#pragma unroll
    for (int i = 0; i < 4; i++) { const float4 v = sp[i]; s += v.x + v.y + v.z + v.w; }
    const float rinv = rsqrtf(s * (1.f / 1024.f) + 1e-6f);
    const float4* xr = (const float4*)((const float*)(p.ws + OFF_X2) + (size_t)row * 1024);
    float4* orow = (float4*)(p.out + (size_t)row * 1024);
#pragma unroll
    for (int i = 0; i < 4; i++) {
      float4 v = xr[lane + 64 * i];
      const float4 g = ((const float4*)p.final_norm)[lane + 64 * i];
      v.x *= rinv * g.x; v.y *= rinv * g.y; v.z *= rinv * g.z; v.w *= rinv * g.w;
      orow[lane + 64 * i] = v;
    }
  }
}

#define XB_TMO      128
#define XB_XCNT(j)  (256  + 64 * (j))
#define XB_XSUB(j)  (1280 + 64 * (j))
#define XB_XGEN(j)  (2304 + 64 * (j))
#define XB_TOP      3328
#define XB_TOPGEN   3392
#define XCD_BAR_WORDS 3456
#define XB_SPIN_CAP (1u << 18)
#define LAS __attribute__((address_space(3)))
DI unsigned xb_ld(unsigned* p) { return __hip_atomic_load(p, __ATOMIC_RELAXED, __HIP_MEMORY_SCOPE_AGENT); }
DI unsigned xb_add(unsigned* p, unsigned v) { return __hip_atomic_fetch_add(p, v, __ATOMIC_RELAXED, __HIP_MEMORY_SCOPE_AGENT); }
DI unsigned xb_xcc_id() { return (unsigned)__builtin_amdgcn_s_getreg((3 << 11) | 20) & 0xFu; }
#define XB_SPIN(cond, bar) do { unsigned _sp = 0; while (cond) { __builtin_amdgcn_s_sleep(1); \
    if ((++_sp & 255u) == 0u) { if (xb_ld(&(bar)[XB_TMO])) break; if (_sp > XB_SPIN_CAP) { atomicAdd(&(bar)[XB_TMO], 1u); break; } } } } while (0)
struct XcdBarrier { unsigned* bar; unsigned x; volatile LAS unsigned* st; };
DI XcdBarrier xcd_barrier_post(unsigned* bar, volatile LAS unsigned* st) {
  XcdBarrier b; b.bar = bar; b.x = xb_xcc_id(); b.st = st;
  if (threadIdx.x == 0) (void)xb_add(&bar[XB_XCNT(b.x)], 1u);
  return b;
}
DI void xcd_barrier_complete(unsigned* bar, unsigned x, unsigned& nloc, unsigned& nx) {
  const unsigned G = gridDim.x;
  unsigned sum, cnt, mine, sp = 0u;
  for (;;) {
    sum = 0u; cnt = 0u; mine = 0u;
#pragma unroll
    for (unsigned j = 0; j < 16; ++j) { const unsigned c = xb_ld(&bar[XB_XCNT(j)]); sum += c; cnt += (c > 0u) ? 1u : 0u; mine = (j == x) ? c : mine; }
    if (sum == G) break;
    __builtin_amdgcn_s_sleep(1);
    if ((++sp & 255u) == 0u) { if (xb_ld(&bar[XB_TMO])) break; if (sp > XB_SPIN_CAP) { atomicAdd(&bar[XB_TMO], 1u); break; } }
  }
  nloc = mine > 0u ? mine : 1u; nx = cnt > 0u ? cnt : 1u;
}
DI void xcd_barrier(const XcdBarrier& b) {
  asm volatile("s_waitcnt vmcnt(0)" ::: "memory");
  __syncthreads();
  if (threadIdx.x == 0) {
    unsigned* bar = b.bar;
    __builtin_amdgcn_s_waitcnt(0);
    unsigned nloc = b.st[0], nx = b.st[1];
    if (nloc == 0u) { xcd_barrier_complete(bar, b.x, nloc, nx); b.st[0] = nloc; b.st[1] = nx; }
    const unsigned old = xb_add(&bar[XB_XSUB(b.x)], 1u);
    const unsigned gen = old / nloc;
    if (old + 1u == (gen + 1u) * nloc) {
      __builtin_amdgcn_fence(__ATOMIC_RELEASE, "agent");
      asm volatile("s_waitcnt vmcnt(0)" ::: "memory");
      const unsigned og = xb_add(&bar[XB_TOP], 1u);
      const unsigned tg = og / nx;
      if (og + 1u == (tg + 1u) * nx) xb_add(&bar[XB_TOPGEN], 1u);
      else XB_SPIN(xb_ld(&bar[XB_TOPGEN]) == tg, bar);
      __builtin_amdgcn_fence(__ATOMIC_ACQUIRE, "agent");
      xb_add(&bar[XB_XGEN(b.x)], 1u);
      asm volatile("s_waitcnt vmcnt(0)" ::: "memory");
    } else {
      XB_SPIN(xb_ld(&bar[XB_XGEN(b.x)]) == gen, bar);
      __builtin_amdgcn_fence(__ATOMIC_ACQUIRE, "agent");
      asm volatile("s_waitcnt vmcnt(0)" ::: "memory");
    }
  }
  __syncthreads();
}

constexpr int SMEM_BYTES = 56320;
__global__ void __launch_bounds__(256, 2) yoco_fwd(Params p) {
  __shared__ __attribute__((aligned(16))) unsigned char smem[SMEM_BYTES];
  __shared__ uint4 xb_words;
  unsigned char* ws = p.ws;
  if (threadIdx.x == 0) xb_words = make_uint4(0u, 0u, 0u, 0u);
  __syncthreads();
  const XcdBarrier xb = xcd_barrier_post((unsigned*)(ws + OFF_BAR), (volatile LAS unsigned*)&xb_words);
  if (p.out == nullptr) {
    const unsigned long long mg = *(const volatile unsigned long long*)((const char*)__builtin_amdgcn_implicitarg_ptr() + 88);
    if (mg == 1ull) ((volatile unsigned*)(ws + OFF_BAR))[XB_TMO] = 1u;
  }
#ifndef DUP
#define DUP 0
#endif
#ifndef PHM
#define PHM 0xfff
#endif
#define RUNP(bit, call) { if (PHM & bit) { call; } xcd_barrier(xb); if (DUP & bit) { call; xcd_barrier(xb); } }
  RUNP(1, phase0(p, smem))
  RUNP(2, phase1(p, smem))
  RUNP(4, phase2(p, smem))
  RUNP(8, phase_res_gemm((const h16*)(ws + OFF_Y), LDY, 1280, (const h16*)(ws + OFF_WOA), p.x, nullptr, (h16*)(ws + OFF_X1H), (float*)(ws + OFF_SSQX1), smem))
  RUNP(16, phase4(p, smem))
  RUNP(32, phase5(p, smem))
  RUNP(64, phase6(p, smem))
  if (PHM & 128) phase_final(p, smem);
}

extern "C" void kernel_launch(void* const* d_in, const int* in_sizes, int n_in, void* d_out, int out_size, void* d_ws,
                              size_t ws_size, hipStream_t stream) {
  static int grid_blocks = 0;
  static int cus_s = 0;
  if (!grid_blocks) {
    int dev = 0, cus = 0;
    (void)hipGetDevice(&dev);
    (void)hipDeviceGetAttribute(&cus, hipDeviceAttributeMultiprocessorCount, dev);
    if (cus < 8) cus = 256;
    cus -= cus % 8;
    cus_s = cus;
    grid_blocks = cus * 2;
  }
  Params p{};
  const float** pp = (const float**)&p;
  for (int i = 0; i < 22; i++) pp[i] = (const float*)d_in[i];
  p.out = (float*)d_out;
  p.ws = (unsigned char*)d_ws;
  (void)hipMemsetAsync((unsigned char*)d_ws + OFF_BAR, 0, XCD_BAR_WORDS * sizeof(unsigned), stream);
  void* args[] = {&p};
  hipError_t e = hipLaunchCooperativeKernel((void*)yoco_fwd, dim3(grid_blocks), dim3(256), args, 0, stream);
  if (e != hipSuccess && grid_blocks != cus_s) {
    (void)hipGetLastError();
    grid_blocks = cus_s;
    e = hipLaunchCooperativeKernel((void*)yoco_fwd, dim3(grid_blocks), dim3(256), args, 0, stream);
  }
  if (e != hipSuccess) fprintf(stderr, "cooperative launch failed: %s (grid %d)\n", hipGetErrorString(e), grid_blocks);
}
```

```cpp
#include <hip/hip_runtime.h>
#include <hip/hip_cooperative_groups.h>
#include <cstdio>
namespace cg = cooperative_groups;

typedef _Float16 h16;
typedef __attribute__((ext_vector_type(8))) _Float16 h16x8;
typedef __attribute__((ext_vector_type(4))) _Float16 h16x4;
typedef __attribute__((ext_vector_type(16))) float f32x16;
typedef __attribute__((ext_vector_type(4))) unsigned u32x4;

#define DI __device__ __forceinline__
#define MFMA(a, b, c) __builtin_amdgcn_mfma_f32_32x32x16_f16((a), (b), (c), 0, 0, 0)

constexpr int M_TOK = 32768;
constexpr int SEQ = 2048;
constexpr size_t MiB = 1u << 20;
constexpr int LD1K = 1088;
constexpr int LDY = 1344;
constexpr int LDKV = 320;
constexpr size_t OFF_W1T = 0;
constexpr size_t OFF_WRG = 5 * MiB + 512 * 1024;
constexpr size_t OFF_WIG = 6 * MiB;
constexpr size_t OFF_WOA = 6 * MiB + 512 * 1024;
constexpr size_t OFF_W4T = 9 * MiB + 512 * 1024;
constexpr size_t OFF_W5KV = 13 * MiB + 512 * 1024;
constexpr size_t OFF_W5Q = 15 * MiB;
constexpr size_t OFF_WOB = 16 * MiB + 512 * 1024;
constexpr size_t OFF_COS = 19 * MiB;
constexpr size_t OFF_SIN = OFF_COS + 256 * 1024;
constexpr size_t OFF_SSQX1 = 19 * MiB + 512 * 1024;
constexpr size_t OFF_SSQKV = 21 * MiB + 512 * 1024;
constexpr size_t OFF_SSQQ = 22 * MiB;
constexpr size_t OFF_SSQO = 23 * MiB;
constexpr size_t OFF_BAR = 25 * MiB;
constexpr size_t SLOT1 = 26 * MiB;
constexpr size_t SLOT2 = 110 * MiB;
constexpr size_t SLOT3 = 270 * MiB;
constexpr size_t OFF_H0 = SLOT1, OFF_Y = SLOT1, OFF_CKV = SLOT1, OFF_CQ = SLOT1 + 24 * MiB, OFF_Y2 = SLOT1;
constexpr size_t OFF_XB = SLOT2, OFF_SG = SLOT2 + 80 * MiB, OFF_X1H = 436 * MiB  , OFF_Q = SLOT2, OFF_SG2 = SLOT2 + 96 * MiB;
constexpr size_t OFF_X2 = SLOT2;
constexpr size_t OFF_TAGS = 432 * MiB;
constexpr size_t OFF_KF = SLOT3  , OFF_KR = SLOT3 + 64 * MiB  , OFF_VT = SLOT3 + 96 * MiB;

struct Params {
  const float *x, *norm_a, *w_in_a, *conv_w, *conv_b, *w_rg, *b_rg, *w_ig, *b_ig, *lam, *w_out_a;
  const float *norm_kv, *w_dkv, *kv_norm, *w_uk, *w_uv, *norm_b, *w_in_b, *q_norm, *w_uq, *w_out_b, *final_norm;
  float* out;
  unsigned char* ws;
};

DI int crow(int i, int h) { return (i & 3) + 8 * (i >> 2) + 4 * h; }
DI constexpr int crow0(int i) { return (i & 3) + 8 * (i >> 2); }
DI float fexp2(float x) { return __builtin_amdgcn_exp2f(x); }
DI float frcp(float x) { return __builtin_amdgcn_rcpf(x); }
DI float silu_f(float v) { return v * frcp(1.f + fexp2(-1.44269504f * v)); }
DI float wave_sum(float v) {
#pragma unroll
  for (int o = 32; o; o >>= 1) v += __shfl_xor(v, o);
  return v;
}
DI float half_sum32(float v) {
#pragma unroll
  for (int o = 16; o; o >>= 1) v += __shfl_xor(v, o);
  return v;
}
DI int ptid() { int t = __builtin_amdgcn_workitem_id_x(); asm volatile("" : "+v"(t)); return t; }
DI int vblock() { return (blockIdx.x & 7) * (gridDim.x >> 3) + (blockIdx.x >> 3); }
DI int round_item(int k, int n) {
  const int G = gridDim.x, base = k * G;
  if (base + G <= n) return base + vblock();
  const int t = base + (int)blockIdx.x;
  return t < n ? t : -1;
}

DI void transpose_tile(const float* __restrict__ src, int ld, int n_off, h16* __restrict__ dst, int dst_ld, int row_off,
                       const float* __restrict__ gain, int tn, int tk, float* lds) {
  const int tid = ptid();
  const int k0 = tk * 64, n0 = tn * 64;
#pragma unroll
  for (int i = 0; i < 4; i++) {
    const int idx = tid + 256 * i, kk = idx >> 4, n4 = idx & 15;
    const float4 v = *(const float4*)(src + (size_t)(k0 + kk) * ld + n_off + n0 + n4 * 4);
    const float g = gain ? gain[k0 + kk] : 1.f;
    float* d = lds + kk * 65 + n4 * 4;
    d[0] = v.x * g; d[1] = v.y * g; d[2] = v.z * g; d[3] = v.w * g;
  }
  __syncthreads();
#pragma unroll
  for (int i = 0; i < 2; i++) {
    const int idx = tid + 256 * i, nn = idx >> 3, kc = idx & 7;
    h16x8 o;
#pragma unroll
    for (int j = 0; j < 8; j++) o[j] = (h16)lds[(kc * 8 + j) * 65 + nn];
    *(h16x8*)(dst + (size_t)(row_off + n0 + nn) * dst_ld + k0 + kc * 8) = o;
  }
  __syncthreads();
}

DI void phase0(const Params& p, unsigned char* smem) {
  float* lds = (float*)smem;
  unsigned char* ws = p.ws;
  const int tid = ptid(), lane = tid & 63;
  for (int t = blockIdx.x; t < 2000; t += gridDim.x) {
    int u = t;
    if (u < 640) { transpose_tile(p.w_in_a, 2560, 0, (h16*)(ws + OFF_W1T), LD1K, 0, nullptr, u % 40, u / 40, lds); continue; }
    u -= 640;
    if (u < 80) {
      const int which = u / 40, n = (u % 40) >> 2, tn = u & 1, tk = (u >> 1) & 1;
      transpose_tile((which ? p.w_ig : p.w_rg) + n * 16384, 128, 0, (h16*)(ws + (which ? OFF_WIG : OFF_WRG)), 128, n * 128, nullptr, tn, tk, lds);
      continue;
    }
    u -= 80;
    if (u < 320) { transpose_tile(p.w_out_a, 1024, 0, (h16*)(ws + OFF_WOA), LDY, 0, nullptr, u % 16, u / 16, lds); continue; }
    u -= 320;
    if (u < 64) { transpose_tile(p.w_dkv, 320, 0, (h16*)(ws + OFF_W4T), LD1K, 0, p.norm_kv, u % 4, u / 4, lds); continue; }
    u -= 64;
    if (u < 96) { transpose_tile(p.w_in_b, 1408, 0, (h16*)(ws + OFF_W4T), LD1K, 256, p.norm_b, u % 6, u / 6, lds); continue; }
    u -= 96;
    if (u < 256) { transpose_tile(p.w_in_b, 1408, 384, (h16*)(ws + OFF_W4T), LD1K, 640, p.norm_b, u % 16, u / 16, lds); continue; }
    u -= 256;
    if (u < 16) { transpose_tile(p.w_dkv, 320, 256, (h16*)(ws + OFF_W4T), LD1K, 1664, p.norm_kv, 0, u, lds); continue; }
    u -= 16;
    if (u < 64) { transpose_tile(p.w_uk, 1024, 0, (h16*)(ws + OFF_W5KV), LDKV, 0, p.kv_norm, u % 16, u / 16, lds); continue; }
    u -= 64;
    if (u < 64) { transpose_tile(p.w_uv, 1024, 0, (h16*)(ws + OFF_W5KV), LDKV, 1024, p.kv_norm, u % 16, u / 16, lds); continue; }
    u -= 64;
    if (u < 144) { transpose_tile(p.w_uq, 1536, 0, (h16*)(ws + OFF_W5Q), 384, 0, p.q_norm, u % 24, u / 24, lds); continue; }
    u -= 144;
    transpose_tile(p.w_out_b, 1024, 0, (h16*)(ws + OFF_WOB), LD1K, 0, nullptr, u % 16, u / 16, lds);
  }
  {
    u32x4* tz = (u32x4*)(ws + OFF_TAGS);
    for (int e = blockIdx.x * 256 + tid; e < M_TOK * 16 * 8 / 16; e += gridDim.x * 256) tz[e] = (u32x4){0u, 0u, 0u, 0u};
  }
  {
    h16* z = (h16*)(ws + OFF_W4T) + (size_t)1728 * LD1K;
    for (int e = blockIdx.x * 256 + tid; e < 64 * LD1K; e += gridDim.x * 256) z[e] = (h16)0.f;
  }
  {
    float* ct = (float*)(ws + OFF_COS);
    float* st = (float*)(ws + OFF_SIN);
    for (int e = blockIdx.x * 256 + tid; e < SEQ * 32; e += gridDim.x * 256) {
      const int pos = e >> 5, i = e & 31;
      const float inv = powf(10000.f, -(float)(2 * i) / 64.f);
      const float ang = (float)pos * inv;
      const double a = (double)ang;
      const double k = rint(a * 0.15915494309189535);
      const float rr = (float)(a - k * 6.283185307179586);
      ct[e] = cosf(rr);
      st[e] = sinf(rr);
    }
  }
  {
    h16* h0 = (h16*)(ws + OFF_H0);
    const int nwv = gridDim.x * 4;
    const int rpw = (((M_TOK + nwv - 1) / nwv) + 3) & ~3;
    const int rbase = (blockIdx.x * 4 + (tid >> 6)) * rpw;
    float4 g[4];
#pragma unroll
    for (int i = 0; i < 4; i++) g[i] = ((const float4*)p.norm_a)[lane + 64 * i];
    for (int k = 0; k < rpw && rbase + k < M_TOK; k += 4) {
      float4 v[4][4];
#pragma unroll
      for (int u = 0; u < 4; u++) {
        const float4* xr = (const float4*)(p.x + (size_t)(rbase + k + u) * 1024);
#pragma unroll
        for (int i = 0; i < 4; i++) v[u][i] = xr[lane + 64 * i];
      }
#pragma unroll
      for (int u = 0; u < 4; u++) {
        float ss = 0.f;
#pragma unroll
        for (int i = 0; i < 4; i++) ss += v[u][i].x * v[u][i].x + v[u][i].y * v[u][i].y + v[u][i].z * v[u][i].z + v[u][i].w * v[u][i].w;
        ss = wave_sum(ss);
        const float rinv = rsqrtf(ss * (1.f / 1024.f) + 1e-6f);
#pragma unroll
        for (int i = 0; i < 4; i++) {
          h16x4 o;
          o[0] = (h16)(v[u][i].x * rinv * g[i].x);
          o[1] = (h16)(v[u][i].y * rinv * g[i].y);
          o[2] = (h16)(v[u][i].z * rinv * g[i].z);
          o[3] = (h16)(v[u][i].w * rinv * g[i].w);
          *(h16x4*)(h0 + (size_t)(rbase + k + u) * LD1K + (lane + 64 * i) * 4) = o;
        }
      }
    }
  }
}

constexpr int LROW = 144;
constexpr int MI = 4;
constexpr int GEMM_LDS = 384 * LROW;
template <bool SWAP, bool PIN = false>
DI void gemm_mainloop(const h16* __restrict__ A, int lda, const h16* __restrict__ Bt, int ldb, int K, int m0, int n0,
                      unsigned char* smem, f32x16 (&acc)[MI][2], int kstart = 0) {
  const int tid = ptid(), lane = tid & 63, w = tid >> 6;
  const int r = lane & 31, h = lane >> 5;
  const int wm = w >> 1, wn = w & 1;
  const int seg = tid & 7, lrow = tid >> 3;
  const unsigned char* Ab = (const unsigned char*)(A + (size_t)m0 * lda);
  const unsigned char* Bb = (const unsigned char*)(Bt + (size_t)n0 * ldb);
  const unsigned offa0 = (unsigned)(lrow * lda + seg * 8) * 2u, offb0 = (unsigned)(lrow * ldb + seg * 8) * 2u;
  int kcur = kstart;
  unsigned offa = offa0 + (unsigned)kcur * 128u, offb = offb0 + (unsigned)kcur * 128u;
  u32x4 st[12];
#pragma unroll
  for (int i = 0; i < 8; i++) st[i] = *(const u32x4*)(Ab + (size_t)i * 64 * lda + offa);
#pragma unroll
  for (int i = 0; i < 4; i++) st[8 + i] = *(const u32x4*)(Bb + (size_t)i * 64 * ldb + offb);
#pragma unroll
  for (int mi = 0; mi < MI; mi++)
#pragma unroll
    for (int ni = 0; ni < 2; ni++)
#pragma unroll
      for (int i = 0; i < 16; i++) acc[mi][ni][i] = 0.f;
  const int nk = K >> 6;
  unsigned char* wA = smem + lrow * LROW + seg * 16;
  const unsigned char* rA = smem + (wm * 128 + r) * LROW + h * 16;
  const unsigned char* rB = smem + (256 + wn * 64 + r) * LROW + h * 16;
  for (int kt = 0; kt < nk; kt++) {
#pragma unroll
    for (int i = 0; i < 12; i++) *(u32x4*)(wA + i * 32 * LROW) = st[i];
    __syncthreads();
    if (kt + 1 < nk) {
      kcur = (kcur + 1 == nk) ? 0 : kcur + 1;
      offa = offa0 + (unsigned)kcur * 128u;
      offb = offb0 + (unsigned)kcur * 128u;
#pragma unroll
      for (int i = 0; i < 8; i++) st[i] = *(const u32x4*)(Ab + (size_t)i * 64 * lda + offa);
#pragma unroll
      for (int i = 0; i < 4; i++) st[8 + i] = *(const u32x4*)(Bb + (size_t)i * 64 * ldb + offb);
    }
    if (PIN) __builtin_amdgcn_sched_barrier(0);
#pragma unroll
    for (int ks = 0; ks < 4; ks++) {
      h16x8 af[MI], bf[2];
#pragma unroll
      for (int mi = 0; mi < MI; mi++) af[mi] = *(const h16x8*)(rA + mi * 32 * LROW + ks * 32);
      bf[0] = *(const h16x8*)(rB + ks * 32);
      bf[1] = *(const h16x8*)(rB + 32 * LROW + ks * 32);
#pragma unroll
      for (int mi = 0; mi < MI; mi++)
#pragma unroll
        for (int ni = 0; ni < 2; ni++)
          acc[mi][ni] = SWAP ? MFMA(bf[ni], af[mi], acc[mi][ni]) : MFMA(af[mi], bf[ni], acc[mi][ni]);
    }
    __syncthreads();
  }
}


constexpr int STG_ROW = 144;
constexpr int STG_WAVE = 64 * STG_ROW;
DI void stage_put(unsigned char* wl, int r, int h, int ni, int gi, h16x4 o) {
  *(h16x4*)(wl + r * STG_ROW + (ni * 32 + 8 * gi + 4 * h) * 2) = o;
}
DI void stage_fence() {
  __builtin_amdgcn_fence(__ATOMIC_ACQ_REL, "wavefront");
  __builtin_amdgcn_wave_barrier();
}
DI void stage_flush(const unsigned char* wl, int lane, h16* grow0, size_t ld) {
  stage_fence();
#pragma unroll
  for (int k = 0; k < 4; k++) {
    const int idx = lane + 64 * k, row = idx >> 3, seg = idx & 7;
    const u32x4 v = *(const u32x4*)(wl + row * STG_ROW + seg * 16);
    *(u32x4*)(grow0 + (size_t)row * ld + seg * 8) = v;
  }
  stage_fence();
}

DI void phase1(const Params& p, unsigned char* smem) {
  unsigned char* ws = p.ws;
  const h16* A = (const h16*)(ws + OFF_H0);
  const h16* Bt = (const h16*)(ws + OFF_W1T);
  h16* xb = (h16*)(ws + OFF_XB);
  h16* sg = (h16*)(ws + OFF_SG);
  const int lane = ptid() & 63, w = ptid() >> 6, r = lane & 31, h = lane >> 5, wm = w >> 1, wn = w & 1;
  for (int t = vblock(); t < 128 * 20; t += gridDim.x) {
    const int m0 = (t / 20) * 256, n0 = (t % 20) * 128;
    f32x16 acc[MI][2];
    const int nb = n0 + wn * 64;
    if (n0 >= 1280) {
      gemm_mainloop<false>(A, LD1K, Bt, LD1K, 1024, m0, n0, smem, acc, (t * 5) & 15);
#pragma unroll
      for (int mi = 0; mi < MI; mi++)
#pragma unroll
        for (int ni = 0; ni < 2; ni++) {
          const int tb = (m0 + wm * 128 + mi * 32) >> 5, cb = (nb - 1280 + ni * 32) >> 5;
          h16x8 v0, v1;
#pragma unroll
          for (int i = 0; i < 8; i++) {
            v0[i] = (h16)silu_f(acc[mi][ni][i]);
            v1[i] = (h16)silu_f(acc[mi][ni][8 + i]);
          }
          h16* d = sg + (((size_t)tb * 40 + cb) * 64 + lane) * 16;
          *(h16x8*)d = v0;
          *(h16x8*)(d + 8) = v1;
        }
    } else {
      gemm_mainloop<true>(A, LD1K, Bt, LD1K, 1024, m0, n0, smem, acc, (t * 5) & 15);
      unsigned char* wl = smem + w * STG_WAVE;
#pragma unroll
      for (int mi = 0; mi < MI; mi++) {
#pragma unroll
        for (int ni = 0; ni < 2; ni++)
#pragma unroll
          for (int gi = 0; gi < 4; gi++) {
            h16x4 o;
#pragma unroll
            for (int j = 0; j < 4; j++) o[j] = (h16)acc[mi][ni][gi * 4 + j];
            stage_put(wl, r, h, ni, gi, o);
          }
        stage_flush(wl, lane, xb + (size_t)(m0 + wm * 128 + mi * 32) * 1280 + nb, 1280);
      }
    }
    __syncthreads();
  }
}

DI void phase2(const Params& p, unsigned char* smem) {
  unsigned char* ws = p.ws;
  const h16* xb = (const h16*)(ws + OFF_XB);
  const h16* sg = (const h16*)(ws + OFF_SG);
  h16* y = (h16*)(ws + OFF_Y);
  const h16* Wrg = (const h16*)(ws + OFF_WRG);
  const h16* Wig = (const h16*)(ws + OFF_WIG);
  h16* As = (h16*)smem;
  h16* cw_s = (h16*)(smem + 34816);
  h16* cb_s = (h16*)(smem + 36864);
  float* agg = (float*)(smem + 37376);
  h16* Ys = (h16*)(smem + 38400);
  const int tid = ptid(), lane = tid & 63, w = tid >> 6, r = lane & 31, h = lane >> 5;
  const float L2E = 1.44269504f;
  for (int rk = 0; rk * (int)gridDim.x < 640; rk++) {
    const int it = round_item(rk, 640);
    if (it < 0) break;
    const int b = it / 40, n = (it % 40) >> 2, q = it & 3;
    __syncthreads();
    if (tid < 128) {
      cb_s[tid] = (h16)p.conv_b[n * 128 + tid];
#pragma unroll
      for (int k = 0; k < 4; k++) cw_s[k * 128 + tid] = (h16)p.conv_w[k * 1280 + n * 128 + tid];
    }
    h16x8 brg[8], big[8];
    {
      const h16* wr = Wrg + (size_t)(n * 128 + q * 32 + r) * 128 + h * 8;
      const h16* wi = Wig + (size_t)(n * 128 + q * 32 + r) * 128 + h * 8;
#pragma unroll
      for (int ks = 0; ks < 8; ks++) {
        brg[ks] = *(const h16x8*)(wr + ks * 16);
        big[ks] = *(const h16x8*)(wi + ks * 16);
      }
    }
    const int ch = n * 128 + q * 32 + r;
    const float cbr = -L2E * p.b_rg[ch], cbi = -L2E * p.b_ig[ch];
    const float cch2 = -8.f * L2E * log1pf(expf(-p.lam[ch]));
    float hc = 0.f;
    const int cgp = tid & 15, rgp = tid >> 4;
    const h16* src = xb + ((size_t)(b * SEQ) + rgp * 8 - 3) * 1280 + n * 128 + cgp * 8;
    u32x4 xin[11];
#pragma unroll
    for (int j = 0; j < 11; j++) {
      if (rgp == 0 && j < 3) xin[j] = (u32x4){0u, 0u, 0u, 0u};
      else xin[j] = *(const u32x4*)(src + (ptrdiff_t)j * 1280);
    }
    __syncthreads();
    for (int c = 0; c < 16; c++) {
      {
        const h16x8 w0 = *(const h16x8*)(cw_s + 0 * 128 + cgp * 8), w1 = *(const h16x8*)(cw_s + 1 * 128 + cgp * 8);
        const h16x8 w2 = *(const h16x8*)(cw_s + 2 * 128 + cgp * 8), w3 = *(const h16x8*)(cw_s + 3 * 128 + cgp * 8);
        const h16x8 bb = *(const h16x8*)(cb_s + cgp * 8);
#pragma unroll
        for (int o = 0; o < 8; o++) {
          h16x8 a = w0 * __builtin_bit_cast(h16x8, xin[o]) + bb;
          a = w1 * __builtin_bit_cast(h16x8, xin[o + 1]) + a;
          a = w2 * __builtin_bit_cast(h16x8, xin[o + 2]) + a;
          a = w3 * __builtin_bit_cast(h16x8, xin[o + 3]) + a;
          *(h16x8*)(As + (rgp * 8 + o) * 136 + cgp * 8) = a;
        }
      }
      __syncthreads();
      if (c + 1 < 16) {
        const h16* s2 = src + (size_t)(c + 1) * 128 * 1280;
#pragma unroll
        for (int j = 0; j < 11; j++) xin[j] = *(const u32x4*)(s2 + (ptrdiff_t)j * 1280);
      }
      __builtin_amdgcn_sched_barrier(0);
      const int tb = (b * SEQ + c * 128 + w * 32) >> 5, cbk = n * 4 + q;
      const h16* sgp = sg + (((size_t)tb * 40 + cbk) * 64 + lane) * 16;
      const h16x8 sg0 = *(const h16x8*)sgp, sg1 = *(const h16x8*)(sgp + 8);
      f32x16 ar, ai;
#pragma unroll
      for (int i = 0; i < 16; i++) { ar[i] = 0.f; ai[i] = 0.f; }
      {
        const unsigned char* rA = (const unsigned char*)As + (w * 32 + r) * 272 + h * 16;
#pragma unroll
        for (int ks = 0; ks < 8; ks++) {
          const h16x8 a = *(const h16x8*)(rA + ks * 32);
          ar = MFMA(a, brg[ks], ar);
          ai = MFMA(a, big[ks], ai);
        }
      }
      float P[16], H[16], SA[4], SB[4];
#pragma unroll
      for (int gi = 0; gi < 4; gi++) {
        float pp = 1.f, hh = 0.f;
#pragma unroll
        for (int j = 0; j < 4; j++) {
          const int i = gi * 4 + j;
          const int tok = w * 32 + 8 * gi + 4 * h + j;
          const float xc = (float)As[tok * 136 + q * 32 + r];
          const float a1 = fminf(fmaf(ar[i], -L2E, cbr), 60.f), a2 = fminf(fmaf(ai[i], -L2E, cbi), 60.f);
          const float t1 = 1.f + fexp2(a1), t2 = 1.f + fexp2(a2);
          const float inv = frcp(t1 * t2);
          const float rs = t2 * inv, is = t1 * inv;
          const float a = fexp2(cch2 * rs);
          const float om = fmaf(-a, a, 1.f);
          const float bt = __builtin_amdgcn_sqrtf(om) * is * xc;
          hh = a * hh + bt;
          pp = a * pp;
          P[i] = pp;
          H[i] = hh;
        }
        SA[gi] = pp;
        SB[gi] = hh;
      }
      float CA = 1.f, CB = 0.f, inA[4], inB[4];
#pragma unroll
      for (int gi = 0; gi < 4; gi++) {
        const float oa = __shfl_xor(SA[gi], 32), ob = __shfl_xor(SB[gi], 32);
        const float a0 = h ? oa : SA[gi], b0 = h ? ob : SB[gi];
        const float a1 = h ? SA[gi] : oa, b1 = h ? SB[gi] : ob;
        const float ca0 = CA, cb0 = CB;
        CB = a0 * CB + b0;
        CA = a0 * CA;
        inA[gi] = h ? CA : ca0;
        inB[gi] = h ? CB : cb0;
        CB = a1 * CB + b1;
        CA = a1 * CA;
      }
      if (h == 0) {
        agg[(w * 32 + r) * 2] = CA;
        agg[(w * 32 + r) * 2 + 1] = CB;
      }
      __syncthreads();
      float hin = hc, hrun = hc;
#pragma unroll
      for (int w2 = 0; w2 < 4; w2++) {
        const float a = agg[(w2 * 32 + r) * 2], bb = agg[(w2 * 32 + r) * 2 + 1];
        if (w2 == w) hin = hrun;
        hrun = a * hrun + bb;
      }
      hc = hrun;
#pragma unroll
      for (int gi = 0; gi < 4; gi++) {
        const float hs = inA[gi] * hin + inB[gi];
#pragma unroll
        for (int j = 0; j < 4; j++) {
          const int i = gi * 4 + j;
          const int tok = w * 32 + 8 * gi + 4 * h + j;
          const float hv = H[i] + P[i] * hs;
          const float g = (float)(i < 8 ? sg0[i & 7] : sg1[i & 7]);
          Ys[tok * 40 + r] = (h16)(hv * g);
        }
      }
      __syncthreads();
#pragma unroll
      for (int k = 0; k < 2; k++) {
        const int idx = tid + 256 * k, row = idx >> 2, seg = idx & 3;
        *(u32x4*)(y + ((size_t)(b * SEQ + c * 128 + row)) * LDY + n * 128 + q * 32 + seg * 8) = *(const u32x4*)(Ys + row * 40 + seg * 8);
      }
    }
  }
}

DI void phase_res_gemm(const h16* __restrict__ A, int ld, int K, const h16* __restrict__ Bt, const float* __restrict__ res, float* __restrict__ outp, h16* __restrict__ outh, float* __restrict__ ssq,
                       unsigned char* smem) {
  const int lane = ptid() & 63, w = ptid() >> 6, r = lane & 31, h = lane >> 5, wm = w >> 1, wn = w & 1;
  for (int t = vblock(); t < 128 * 8; t += gridDim.x) {
    const int m0 = (t >> 3) * 256, n0 = (t & 7) * 128;
    f32x16 acc[MI][2];
    gemm_mainloop<true>(A, ld, Bt, ld, K, m0, n0, smem, acc);
    const int nb = n0 + wn * 64;
    unsigned char* wl = smem + w * STG_WAVE;
#pragma unroll
    for (int mi = 0; mi < MI; mi++) {
      const int rowb = m0 + wm * 128 + mi * 32;
      const int row = rowb + r;
#pragma unroll
      for (int k = 0; k < 8; k++) {
        const int idx = lane + 64 * k, rr = idx >> 4, sg4 = idx & 15;
        *(float4*)(wl + rr * 272 + sg4 * 16) = *(const float4*)(res + (size_t)(rowb + rr) * 1024 + nb + sg4 * 4);
      }
      stage_fence();
      float sq = 0.f;
      h16x4 ov[2][4];
#pragma unroll
      for (int ni = 0; ni < 2; ni++)
#pragma unroll
        for (int gi = 0; gi < 4; gi++) {
          float4 v = *(const float4*)(wl + r * 272 + (ni * 32 + 8 * gi + 4 * h) * 4);
          v.x += acc[mi][ni][gi * 4 + 0];
          v.y += acc[mi][ni][gi * 4 + 1];
          v.z += acc[mi][ni][gi * 4 + 2];
          v.w += acc[mi][ni][gi * 4 + 3];
          if (outp) *(float4*)(outp + (size_t)row * 1024 + nb + 4 * h + ni * 32 + 8 * gi) = v;
          ov[ni][gi][0] = (h16)v.x; ov[ni][gi][1] = (h16)v.y; ov[ni][gi][2] = (h16)v.z; ov[ni][gi][3] = (h16)v.w;
          sq += v.x * v.x + v.y * v.y + v.z * v.z + v.w * v.w;
        }
      stage_fence();
#pragma unroll
      for (int ni = 0; ni < 2; ni++)
#pragma unroll
        for (int gi = 0; gi < 4; gi++) stage_put(wl, r, h, ni, gi, ov[ni][gi]);
      stage_flush(wl, lane, outh + (size_t)rowb * LD1K + nb, LD1K);
      sq += __shfl_xor(sq, 32);
      if (h == 0) ssq[(size_t)row * 16 + (nb >> 6)] = sq;
    }
    __syncthreads();
  }
}

DI void phase_final(const Params& p, unsigned char* smem) {
  unsigned char* ws = p.ws;
  const h16* A = (const h16*)(ws + OFF_Y2);
  const h16* Bt = (const h16*)(ws + OFF_WOB);
  const h16* __restrict__ res = (const h16*)(ws + OFF_X1H);
  unsigned long long* tags = (unsigned long long*)(ws + OFF_TAGS);
  const int lane = ptid() & 63, w = ptid() >> 6, r = lane & 31, h = lane >> 5, wm = w >> 1, wn = w & 1;
  for (int t = vblock(); t < 128 * 8; t += gridDim.x) {
    const int m0 = (t >> 3) * 256, n0 = (t & 7) * 128;
    f32x16 acc[MI][2];
    gemm_mainloop<true>(A, LD1K, Bt, LD1K, 1024, m0, n0, smem, acc);
    const int nb = n0 + wn * 64;
#pragma unroll
    for (int mi = 0; mi < MI; mi++) {
      const int row = m0 + wm * 128 + mi * 32 + r;
      float sq = 0.f;
      unsigned char* wlr = smem + w * STG_WAVE;
      {
        const h16* rsrc = res + (size_t)(m0 + wm * 128 + mi * 32) * LD1K + nb;
#pragma unroll
        for (int k = 0; k < 4; k++) {
          const int idx = lane + 64 * k, rr = idx >> 3, sg8 = idx & 7;
          *(u32x4*)(wlr + rr * STG_ROW + sg8 * 16) = *(const u32x4*)(rsrc + (size_t)rr * LD1K + sg8 * 8);
        }
        stage_fence();
      }
#pragma unroll
      for (int ni = 0; ni < 2; ni++)
#pragma unroll
        for (int gi = 0; gi < 4; gi++) {
          const h16x4 v = *(const h16x4*)(wlr + r * STG_ROW + (ni * 32 + 8 * gi + 4 * h) * 2);
#pragma unroll
          for (int j = 0; j < 4; j++) acc[mi][ni][gi * 4 + j] += (float)v[j];
#pragma unroll
          for (int j = 0; j < 4; j++) sq += acc[mi][ni][gi * 4 + j] * acc[mi][ni][gi * 4 + j];
        }
      stage_fence();
      sq += __shfl_xor(sq, 32);
      if (h == 0) {
        const unsigned long long pk = (unsigned long long)__float_as_uint(sq) | (1ull << 32);
        __hip_atomic_store(tags + (size_t)row * 16 + (nb >> 6), pk, __ATOMIC_RELAXED, __HIP_MEMORY_SCOPE_AGENT);
      }
    }
#pragma unroll
    for (int mi = 0; mi < MI; mi++) {
      const int row = m0 + wm * 128 + mi * 32 + r;
      float tot = 0.f;
#pragma unroll
      for (int k = 0; k < 8; k++) {
        unsigned long long* tp = tags + (size_t)row * 16 + 8 * h + k;
        unsigned long long v = __hip_atomic_load(tp, __ATOMIC_RELAXED, __HIP_MEMORY_SCOPE_AGENT);
        unsigned spin = 0;
        while ((unsigned)(v >> 32) != 1u && spin < (1u << 22)) {
          __builtin_amdgcn_s_sleep(1);
          v = __hip_atomic_load(tp, __ATOMIC_RELAXED, __HIP_MEMORY_SCOPE_AGENT);
          ++spin;
        }
        tot += __uint_as_float((unsigned)v);
      }
      tot += __shfl_xor(tot, 32);
      const float rinv = rsqrtf(tot * (1.f / 1024.f) + 1e-6f);
      unsigned char* wl = smem + w * STG_WAVE;
#pragma unroll
      for (int ni = 0; ni < 2; ni++)
#pragma unroll
        for (int gi = 0; gi < 4; gi++) {
          const float4 g = *(const float4*)(p.final_norm + nb + 4 * h + ni * 32 + 8 * gi);
          float4 o;
          o.x = acc[mi][ni][gi * 4 + 0] * rinv * g.x;
          o.y = acc[mi][ni][gi * 4 + 1] * rinv * g.y;
          o.z = acc[mi][ni][gi * 4 + 2] * rinv * g.z;
          o.w = acc[mi][ni][gi * 4 + 3] * rinv * g.w;
          *(float4*)(wl + r * 272 + (ni * 32 + 8 * gi + 4 * h) * 4) = o;
        }
      stage_fence();
      const int rowb = m0 + wm * 128 + mi * 32;
#pragma unroll
      for (int k = 0; k < 8; k++) {
        const int idx = lane + 64 * k, rr = idx >> 4, sg4 = idx & 15;
        *(float4*)(p.out + (size_t)(rowb + rr) * 1024 + nb + sg4 * 4) = *(const float4*)(wl + rr * 272 + sg4 * 16);
      }
      stage_fence();
    }
    __syncthreads();
  }
}

DI void phase4(const Params& p, unsigned char* smem) {
  unsigned char* ws = p.ws;
  const h16* A = (const h16*)(ws + OFF_X1H);
  const h16* Bt = (const h16*)(ws + OFF_W4T);
  const float* ssq = (const float*)(ws + OFF_SSQX1);
  h16* ckv = (h16*)(ws + OFF_CKV);
  h16* cq = (h16*)(ws + OFF_CQ);
  h16* sg2 = (h16*)(ws + OFF_SG2);
  h16* Kf = (h16*)(ws + OFF_KF);
  float* ssqkv = (float*)(ws + OFF_SSQKV);
  float* ssqq = (float*)(ws + OFF_SSQQ);
  const float* ct = (const float*)(ws + OFF_COS);
  const float* st = (const float*)(ws + OFF_SIN);
  float* rinv_s = (float*)(smem + GEMM_LDS);
  const int tid = ptid(), lane = tid & 63, w = tid >> 6, r = lane & 31, h = lane >> 5, wm = w >> 1, wn = w & 1;
  for (int base = 0; base < 128 * 14; base += gridDim.x) {
    const int t = base + ((base + (int)gridDim.x <= 128 * 14) ? vblock() : (int)blockIdx.x);
    if (t >= 128 * 14) break;
    const int m0 = (t / 14) * 256, n0 = (t % 14) * 128;
    {
      const float4* sp = (const float4*)(ssq + (size_t)(m0 + tid) * 16);
      float s = 0.f;
#pragma unroll
      for (int i = 0; i < 4; i++) { const float4 v = sp[i]; s += v.x + v.y + v.z + v.w; }
      rinv_s[tid] = rsqrtf(s * (1.f / 1024.f) + 1e-6f);
    }
    f32x16 acc[MI][2];
    gemm_mainloop<true>(A, LD1K, Bt, LD1K, 1024, m0, n0, smem, acc);
    const int nb = n0 + wn * 64;
    const int sub = nb >> 6;
    const int lr0 = wm * 128 + r;
    const int row0 = m0 + lr0;
    unsigned char* wl = smem + w * STG_WAVE;
    const int rowt = m0 + wm * 128;
    if (sub < 10) {
      const bool iskv = sub < 4;
      h16* gb = iskv ? ckv + (size_t)rowt * LDKV + nb : cq + (size_t)rowt * 384 + (nb - 256);
      const int ld = iskv ? LDKV : 384;
      float* sqb = iskv ? ssqkv + (size_t)row0 * 4 + sub : ssqq + (size_t)row0 * 8 + (sub - 4);
      const int sld = iskv ? 4 : 8;
#pragma unroll
      for (int mi = 0; mi < MI; mi++) {
        const float ri = rinv_s[lr0 + mi * 32];
        float sq = 0.f;
#pragma unroll
        for (int ni = 0; ni < 2; ni++)
#pragma unroll
          for (int gi = 0; gi < 4; gi++) {
            h16x4 o;
#pragma unroll
            for (int j = 0; j < 4; j++) {
              const float v = acc[mi][ni][gi * 4 + j] * ri;
              o[j] = (h16)v;
              sq += v * v;
            }
            stage_put(wl, r, h, ni, gi, o);
          }
        stage_flush(wl, lane, gb + (size_t)mi * 32 * ld, ld);
        sq += __shfl_xor(sq, 32);
        if (h == 0) sqb[mi * 32 * sld] = sq;
      }
    } else if (sub < 26) {
      h16* gb = sg2 + (size_t)rowt * 1024 + (nb - 640);
#pragma unroll
      for (int mi = 0; mi < MI; mi++) {
        const float ri = rinv_s[lr0 + mi * 32];
#pragma unroll
        for (int ni = 0; ni < 2; ni++)
#pragma unroll
          for (int gi = 0; gi < 4; gi++) {
            h16x4 o;
#pragma unroll
            for (int j = 0; j < 4; j++) o[j] = (h16)silu_f(acc[mi][ni][gi * 4 + j] * ri);
            stage_put(wl, r, h, ni, gi, o);
          }
        stage_flush(wl, lane, gb + (size_t)mi * 32 * 1024, 1024);
      }
    } else if (sub == 26) {
      const int b = m0 >> 11, s0 = (m0 & 2047) + lr0;
#pragma unroll
      for (int mi = 0; mi < MI; mi++) {
        const float ri = rinv_s[lr0 + mi * 32];
        const int s = s0 + mi * 32;
#pragma unroll
        for (int gi = 0; gi < 4; gi++) {
          const int j0 = 8 * gi + 4 * h;
          const float4 c = *(const float4*)(ct + s * 32 + j0);
          const float4 sn = *(const float4*)(st + s * 32 + j0);
          const float cc[4] = {c.x, c.y, c.z, c.w}, ss[4] = {sn.x, sn.y, sn.z, sn.w};
          h16x4 o1, o2;
#pragma unroll
          for (int j = 0; j < 4; j++) {
            const float x1 = acc[mi][0][gi * 4 + j] * ri, x2 = acc[mi][1][gi * 4 + j] * ri;
            o1[j] = (h16)(x1 * cc[j] - x2 * ss[j]);
            o2[j] = (h16)(x2 * cc[j] + x1 * ss[j]);
          }
          stage_put(wl, r, h, 0, gi, o1);
          stage_put(wl, r, h, 1, gi, o2);
        }
        stage_flush(wl, lane, (h16*)(ws + OFF_KR) + (size_t)(m0 + wm * 128 + mi * 32) * 64, 64);
      }
    }
    __syncthreads();
  }
}

template <bool ISQ>
DI void phase5_part(const Params& p, unsigned char* smem) {
  unsigned char* ws = p.ws;
  const h16* ckv = (const h16*)(ws + OFF_CKV);
  const h16* cq = (const h16*)(ws + OFF_CQ);
  const h16* Wkv = (const h16*)(ws + OFF_W5KV);
  const h16* Wq = (const h16*)(ws + OFF_W5Q);
  const float* ssqkv = (const float*)(ws + OFF_SSQKV);
  const float* ssqq = (const float*)(ws + OFF_SSQQ);
  h16* Kf = (h16*)(ws + OFF_KF);
  h16* Vt = (h16*)(ws + OFF_VT);
  h16* Q = (h16*)(ws + OFF_Q);
  const float* ct = (const float*)(ws + OFF_COS);
  const float* st = (const float*)(ws + OFF_SIN);
  float* rinv_s = (float*)(smem + GEMM_LDS);
  const int tid = ptid(), lane = tid & 63, w = tid >> 6, r = lane & 31, h = lane >> 5, wm = w >> 1, wn = w & 1;
  const float qscale = 0.07216878364870322f * 1.4426950408889634f;
  constexpr int NTT = ISQ ? 12 : 16;
  for (int t = vblock(); t < 128 * NTT; t += gridDim.x) {
    const int mt = t / NTT, nt = (t % NTT) + (ISQ ? 16 : 0);
    const int m0 = mt * 256;
    const int bb = m0 >> 11;
    const int lr0 = wm * 128 + 4 * h;
    const int s0 = (m0 & 2047) + lr0;
    f32x16 acc[MI][2];
    constexpr bool is_q = ISQ;
    const bool is_v = (nt >= 8) && !is_q;
    {
      float rv;
      if (!is_q) {
        const float4 v = *(const float4*)(ssqkv + (size_t)(m0 + tid) * 4);
        rv = rsqrtf((v.x + v.y + v.z + v.w) * (1.f / 256.f) + 1e-6f);
      } else {
        const float4* sp = (const float4*)(ssqq + (size_t)(m0 + tid) * 8);
        const float4 v0 = sp[0], v1 = sp[1];
        rv = rsqrtf((v0.x + v0.y + v0.z + v0.w + v1.x + v1.y) * (1.f / 384.f) + 1e-6f) * qscale;
      }
      rinv_s[tid] = rv;
    }
    const h16* Ap = is_q ? cq : ckv;
    const h16* Bp = is_q ? Wq : Wkv;
    constexpr int Kd = is_q ? 384 : 256;
    constexpr int ldk = is_q ? 384 : LDKV;
    const int n0 = is_q ? (nt - 16) * 128 : nt * 128;
    gemm_mainloop<true, false>(Ap, ldk, Bp, ldk, Kd, m0, n0, smem, acc);
    const int lrw = wm * 128 + r;
    const int sw = (m0 & 2047) + lrw;
    unsigned char* wl = smem + w * STG_WAVE;
    const int st0 = (m0 & 2047) + wm * 128;
    if (!is_v) {
      const int sub = (n0 >> 6) + wn;
      const int hd = is_q ? sub / 3 : nt;
      const int part = is_q ? sub % 3 : wn;
      const int ldo = is_q ? 192 : 128;
      h16* gb = (is_q ? Q : Kf) + ((size_t)(bb * 8 + hd) * SEQ + st0) * ldo + part * 64;
      if (!is_q || part < 2) {
#pragma unroll
        for (int mi = 0; mi < MI; mi++) {
          const float ri = rinv_s[lrw + mi * 32];
#pragma unroll
          for (int ni = 0; ni < 2; ni++)
#pragma unroll
            for (int gi = 0; gi < 4; gi++) {
              h16x4 o;
#pragma unroll
              for (int j = 0; j < 4; j++) o[j] = (h16)(acc[mi][ni][gi * 4 + j] * ri);
              stage_put(wl, r, h, ni, gi, o);
            }
          stage_flush(wl, lane, gb + (size_t)mi * 32 * ldo, ldo);
        }
      } else {
#pragma unroll
        for (int mi = 0; mi < MI; mi++) {
          const float ri = rinv_s[lrw + mi * 32];
          const int s = sw + mi * 32;
#pragma unroll
          for (int gi = 0; gi < 4; gi++) {
            const int j0 = 8 * gi + 4 * h;
            const float4 c = *(const float4*)(ct + s * 32 + j0);
            const float4 sn = *(const float4*)(st + s * 32 + j0);
            const float cc[4] = {c.x, c.y, c.z, c.w}, ss[4] = {sn.x, sn.y, sn.z, sn.w};
            h16x4 o1, o2;
#pragma unroll
            for (int j = 0; j < 4; j++) {
              const float x1 = acc[mi][0][gi * 4 + j] * ri, x2 = acc[mi][1][gi * 4 + j] * ri;
              o1[j] = (h16)(x1 * cc[j] - x2 * ss[j]);
              o2[j] = (h16)(x2 * cc[j] + x1 * ss[j]);
            }
            stage_put(wl, r, h, 0, gi, o1);
            stage_put(wl, r, h, 1, gi, o2);
          }
          stage_flush(wl, lane, gb + (size_t)mi * 32 * 192, 192);
        }
      }
    } else {
#pragma unroll
      for (int mp = 0; mp < 2; mp++) {
#pragma unroll
        for (int m2 = 0; m2 < 2; m2++) {
          const int mi = mp * 2 + m2;
          const float ri = rinv_s[lrw + mi * 32];
          const int t = m2 * 32 + r;
          const int pos = (t & ~15) + 8 * ((t >> 2) & 1) + 4 * ((t >> 3) & 1) + (t & 3);
#pragma unroll
          for (int ni = 0; ni < 2; ni++)
#pragma unroll
            for (int i = 0; i < 16; i++)
              *(h16*)(wl + (ni * 32 + crow(i, h)) * STG_ROW + pos * 2) = (h16)(acc[mi][ni][i] * ri);
        }
        stage_fence();
        const int kt = (st0 + mp * 64) >> 6;
        h16* gv = Vt + (((size_t)(bb * 8 + (nt - 8)) * 32 + kt) * 128 + wn * 64) * 64;
#pragma unroll
        for (int k = 0; k < 8; k++) {
          const int idx = lane + 64 * k, row = idx >> 3, seg = idx & 7;
          *(u32x4*)(gv + row * 64 + seg * 8) = *(const u32x4*)(wl + row * STG_ROW + seg * 16);
        }
        stage_fence();
      }
    }
    __syncthreads();
  }
}

DI void phase5(const Params& p, unsigned char* smem) {
  phase5_part<false>(p, smem);
  phase5_part<true>(p, smem);
}

constexpr int KROW = 400;
constexpr int VROW = 144;
DI void phase6(const Params& p, unsigned char* smem) {
  unsigned char* ws = p.ws;
  const h16* Q = (const h16*)(ws + OFF_Q);
  const h16* Kf = (const h16*)(ws + OFF_KF);
  const h16* Vt = (const h16*)(ws + OFF_VT);
  const h16* sg2 = (const h16*)(ws + OFF_SG2);
  h16* y2 = (h16*)(ws + OFF_Y2);
  unsigned char* Ks = smem;
  unsigned char* Vs = smem + 64 * KROW;
  const int tid = ptid(), lane = tid & 63, w = tid >> 6, r = lane & 31, h = lane >> 5;
  for (int it2 = vblock() * 2; it2 < 2048; it2 += gridDim.x * 2)
  for (int sel = 0; sel < 2; sel++) {
    const int bh = it2 >> 4, xx = (it2 >> 1) & 7;
    const int qb = sel ? xx : 15 - xx;
    const int b = bh >> 3, hd = bh & 7;
    const int qrow = qb * 128 + w * 32 + r;
    h16x8 qf[12];
    {
      const h16* qp = Q + ((size_t)bh * SEQ + qrow) * 192 + h * 8;
#pragma unroll
      for (int ks = 0; ks < 12; ks++) qf[ks] = *(const h16x8*)(qp + ks * 16);
    }
    f32x16 O[4];
#pragma unroll
    for (int dt = 0; dt < 4; dt++)
#pragma unroll
      for (int i = 0; i < 16; i++) O[dt][i] = 0.f;
    float m = -INFINITY, l = 0.f;
    const int nkt = 2 * qb + 2;
    const h16* kbase = Kf + (size_t)bh * SEQ * 128;
    const h16* rbase = (const h16*)(ws + OFF_KR) + (size_t)b * SEQ * 64;
    const h16* vbase = Vt + (size_t)bh * 128 * SEQ;
    u32x4 kst[6], vst[4];
    const h16* kg = kbase + (size_t)(tid >> 4) * 128 + (tid & 15) * 8;
    const h16* rg = rbase + (size_t)(tid >> 3) * 64 + (tid & 7) * 8;
    const h16* vg = vbase + (size_t)(tid >> 3) * 64 + (tid & 7) * 8;
    unsigned char* kw = Ks + (tid >> 4) * KROW + (tid & 15) * 16;
    unsigned char* rw = Ks + (tid >> 3) * KROW + 256 + (tid & 7) * 16;
    unsigned char* vw = Vs + (tid >> 3) * VROW + (tid & 7) * 16;
#pragma unroll
    for (int i = 0; i < 4; i++) kst[i] = *(const u32x4*)(kg + i * 16 * 128);
#pragma unroll
    for (int i = 0; i < 2; i++) kst[4 + i] = *(const u32x4*)(rg + i * 32 * 64);
#pragma unroll
    for (int i = 0; i < 4; i++) vst[i] = *(const u32x4*)(vg + (size_t)i * 32 * 64);
    for (int kt = 0; kt < nkt; kt++) {
#pragma unroll
      for (int i = 0; i < 4; i++) *(u32x4*)(kw + i * 16 * KROW) = kst[i];
#pragma unroll
      for (int i = 0; i < 2; i++) *(u32x4*)(rw + i * 32 * KROW) = kst[4 + i];
#pragma unroll
      for (int i = 0; i < 4; i++) *(u32x4*)(vw + i * 32 * VROW) = vst[i];
      __syncthreads();
      if (kt + 1 < nkt) {
        kg += 64 * 128;
        rg += 64 * 64;
        vg += 8192;
#pragma unroll
        for (int i = 0; i < 4; i++) kst[i] = *(const u32x4*)(kg + i * 16 * 128);
#pragma unroll
        for (int i = 0; i < 2; i++) kst[4 + i] = *(const u32x4*)(rg + i * 32 * 64);
#pragma unroll
        for (int i = 0; i < 4; i++) vst[i] = *(const u32x4*)(vg + (size_t)i * 32 * 64);
      }
#pragma unroll
      for (int half = 0; half < 2; half++) {
        const int sb = (kt - (nkt - 2)) * 2 + half;
        if (sb > w) continue;
        f32x16 sc;
#pragma unroll
        for (int i = 0; i < 16; i++) sc[i] = 0.f;
        const unsigned char* kr = Ks + (half * 32 + r) * KROW + h * 16;
#pragma unroll
        for (int g = 0; g < 3; g++) {
          h16x8 kf[4];
#pragma unroll
          for (int j = 0; j < 4; j++) kf[j] = *(const h16x8*)(kr + (g * 4 + j) * 32);
#pragma unroll
          for (int j = 0; j < 4; j++) sc = MFMA(kf[j], qf[g * 4 + j], sc);
        }
        if (sb == w) {
#pragma unroll
          for (int i = 0; i < 16; i++)
            if (crow(i, h) > r) sc[i] = -INFINITY;
        }
        float mx = sc[0];
#pragma unroll
        for (int i = 1; i < 16; i++) mx = fmaxf(mx, sc[i]);
        mx = fmaxf(mx, __shfl_xor(mx, 32));
        const float mn = fmaxf(m, mx);
        if (__builtin_amdgcn_ballot_w64(mn > m + 8.f) != 0ull) {
          const float alpha = fexp2(m - mn);
          m = mn;
          l *= alpha;
#pragma unroll
          for (int dt = 0; dt < 4; dt++)
#pragma unroll
            for (int i = 0; i < 16; i++) O[dt][i] *= alpha;
        }
        float ls = 0.f;
#pragma unroll
        for (int i = 0; i < 16; i++) {
          sc[i] = fexp2(sc[i] - m);
          ls += sc[i];
        }
        l += ls;
        h16x8 pf0, pf1;
#pragma unroll
        for (int jj = 0; jj < 8; jj++) {
          pf0[jj] = (h16)sc[jj];
          pf1[jj] = (h16)sc[8 + jj];
        }
        const unsigned char* vr = Vs + r * VROW + h * 16 + half * 64;
#pragma unroll
        for (int dp = 0; dp < 2; dp++) {
          h16x8 vf[4];
#pragma unroll
          for (int j = 0; j < 4; j++) vf[j] = *(const h16x8*)(vr + (dp * 2 + (j >> 1)) * 32 * VROW + (j & 1) * 32);
#pragma unroll
          for (int j = 0; j < 4; j++) O[dp * 2 + (j >> 1)] = MFMA(vf[j], (j & 1) ? pf1 : pf0, O[dp * 2 + (j >> 1)]);
        }
      }
      __syncthreads();
    }
    l += __shfl_xor(l, 32);
    const float inv = 1.f / l;
    {
      unsigned char* wl = smem + w * STG_WAVE;
      const int rowb = b * SEQ + qb * 128 + w * 32;
#pragma unroll
      for (int dp = 0; dp < 2; dp++) {
        const h16* gsrc = sg2 + (size_t)rowb * 1024 + hd * 128 + dp * 64;
#pragma unroll
        for (int k = 0; k < 4; k++) {
          const int idx = lane + 64 * k, rr = idx >> 3, sg8 = idx & 7;
          *(u32x4*)(wl + rr * STG_ROW + sg8 * 16) = *(const u32x4*)(gsrc + (size_t)rr * 1024 + sg8 * 8);
        }
        stage_fence();
        h16x4 ov[2][4];
#pragma unroll
        for (int ni = 0; ni < 2; ni++)
#pragma unroll
          for (int gi = 0; gi < 4; gi++) {
            const h16x4 gt = *(const h16x4*)(wl + r * STG_ROW + (ni * 32 + 8 * gi + 4 * h) * 2);
#pragma unroll
            for (int jj = 0; jj < 4; jj++) ov[ni][gi][jj] = (h16)(O[dp * 2 + ni][gi * 4 + jj] * inv * (float)gt[jj]);
          }
        stage_fence();
#pragma unroll
        for (int ni = 0; ni < 2; ni++)
#pragma unroll
          for (int gi = 0; gi < 4; gi++) stage_put(wl, r, h, ni, gi, ov[ni][gi]);
        stage_flush(wl, lane, y2 + (size_t)rowb * LD1K + hd * 128 + dp * 64, LD1K);
      }
    }
    __syncthreads();
  }
}

DI void phase8(const Params& p) {
  const float* ssq = (const float*)(p.ws + OFF_SSQO);
  const int tid = ptid(), lane = tid & 63;
  const int nw = gridDim.x * 4;
  for (int row = blockIdx.x * 4 + (tid >> 6); row < M_TOK; row += nw) {
    const float4* sp = (const float4*)(ssq + (size_t)row * 16);
    float s = 0.f;
#pragma unroll
    for (int i = 0; i < 4; i++) { const float4 v = sp[i]; s += v.x + v.y + v.z + v.w; }
    const float rinv = rsqrtf(s * (1.f / 1024.f) + 1e-6f);
    const float4* xr = (const float4*)((const float*)(p.ws + OFF_X2) + (size_t)row * 1024);
    float4* orow = (float4*)(p.out + (size_t)row * 1024);
#pragma unroll
    for (int i = 0; i < 4; i++) {
      float4 v = xr[lane + 64 * i];
      const float4 g = ((const float4*)p.final_norm)[lane + 64 * i];
      v.x *= rinv * g.x; v.y *= rinv * g.y; v.z *= rinv * g.z; v.w *= rinv * g.w;
      orow[lane + 64 * i] = v;
    }
  }
}

#define XB_TMO      128
#define XB_XCNT(j)  (256  + 64 * (j))
#define XB_XSUB(j)  (1280 + 64 * (j))
#define XB_XGEN(j)  (2304 + 64 * (j))
#define XB_TOP      3328
#define XB_TOPGEN   3392
#define XCD_BAR_WORDS 3456
#define XB_SPIN_CAP (1u << 18)
#define LAS __attribute__((address_space(3)))
DI unsigned xb_ld(unsigned* p) { return __hip_atomic_load(p, __ATOMIC_RELAXED, __HIP_MEMORY_SCOPE_AGENT); }
DI unsigned xb_add(unsigned* p, unsigned v) { return __hip_atomic_fetch_add(p, v, __ATOMIC_RELAXED, __HIP_MEMORY_SCOPE_AGENT); }
DI unsigned xb_xcc_id() { return (unsigned)__builtin_amdgcn_s_getreg((3 << 11) | 20) & 0xFu; }
#define XB_SPIN(cond, bar) do { unsigned _sp = 0; while (cond) { __builtin_amdgcn_s_sleep(1); \
    if ((++_sp & 255u) == 0u) { if (xb_ld(&(bar)[XB_TMO])) break; if (_sp > XB_SPIN_CAP) { atomicAdd(&(bar)[XB_TMO], 1u); break; } } } } while (0)
struct XcdBarrier { unsigned* bar; unsigned x; volatile LAS unsigned* st; };
DI XcdBarrier xcd_barrier_post(unsigned* bar, volatile LAS unsigned* st) {
  XcdBarrier b; b.bar = bar; b.x = xb_xcc_id(); b.st = st;
  if (threadIdx.x == 0) (void)xb_add(&bar[XB_XCNT(b.x)], 1u);
  return b;
}
DI void xcd_barrier_complete(unsigned* bar, unsigned x, unsigned& nloc, unsigned& nx) {
  const unsigned G = gridDim.x;
  unsigned sum, cnt, mine, sp = 0u;
  for (;;) {
    sum = 0u; cnt = 0u; mine = 0u;
#pragma unroll
    for (unsigned j = 0; j < 16; ++j) { const unsigned c = xb_ld(&bar[XB_XCNT(j)]); sum += c; cnt += (c > 0u) ? 1u : 0u; mine = (j == x) ? c : mine; }
    if (sum == G) break;
    __builtin_amdgcn_s_sleep(1);
    if ((++sp & 255u) == 0u) { if (xb_ld(&bar[XB_TMO])) break; if (sp > XB_SPIN_CAP) { atomicAdd(&bar[XB_TMO], 1u); break; } }
  }
  nloc = mine > 0u ? mine : 1u; nx = cnt > 0u ? cnt : 1u;
}
DI void xcd_barrier(const XcdBarrier& b) {
  asm volatile("s_waitcnt vmcnt(0)" ::: "memory");
  __syncthreads();
  if (threadIdx.x == 0) {
    unsigned* bar = b.bar;
    __builtin_amdgcn_s_waitcnt(0);
    unsigned nloc = b.st[0], nx = b.st[1];
    if (nloc == 0u) { xcd_barrier_complete(bar, b.x, nloc, nx); b.st[0] = nloc; b.st[1] = nx; }
    const unsigned old = xb_add(&bar[XB_XSUB(b.x)], 1u);
    const unsigned gen = old / nloc;
    if (old + 1u == (gen + 1u) * nloc) {
      __builtin_amdgcn_fence(__ATOMIC_RELEASE, "agent");
      asm volatile("s_waitcnt vmcnt(0)" ::: "memory");
      const unsigned og = xb_add(&bar[XB_TOP], 1u);
      const unsigned tg = og / nx;
      if (og + 1u == (tg + 1u) * nx) xb_add(&bar[XB_TOPGEN], 1u);
      else XB_SPIN(xb_ld(&bar[XB_TOPGEN]) == tg, bar);
      __builtin_amdgcn_fence(__ATOMIC_ACQUIRE, "agent");
      xb_add(&bar[XB_XGEN(b.x)], 1u);
      asm volatile("s_waitcnt vmcnt(0)" ::: "memory");
    } else {
      XB_SPIN(xb_ld(&bar[XB_XGEN(b.x)]) == gen, bar);
      __builtin_amdgcn_fence(__ATOMIC_ACQUIRE, "agent");
      asm volatile("s_waitcnt vmcnt(0)" ::: "memory");
    }
  }
  __syncthreads();
}

constexpr int SMEM_BYTES = 56320;
__global__ void __launch_bounds__(256, 2) yoco_fwd(Params p) {
  __shared__ __attribute__((aligned(16))) unsigned char smem[SMEM_BYTES];
  __shared__ uint4 xb_words;
  unsigned char* ws = p.ws;
  if (threadIdx.x == 0) xb_words = make_uint4(0u, 0u, 0u, 0u);
  __syncthreads();
  const XcdBarrier xb = xcd_barrier_post((unsigned*)(ws + OFF_BAR), (volatile LAS unsigned*)&xb_words);
  if (p.out == nullptr) {
    const unsigned long long mg = *(const volatile unsigned long long*)((const char*)__builtin_amdgcn_implicitarg_ptr() + 88);
    if (mg == 1ull) ((volatile unsigned*)(ws + OFF_BAR))[XB_TMO] = 1u;
  }
#ifndef DUP
#define DUP 0
#endif
#ifndef PHM
#define PHM 0xfff
#endif
#define RUNP(bit, call) { if (PHM & bit) { call; } xcd_barrier(xb); if (DUP & bit) { call; xcd_barrier(xb); } }
  RUNP(1, phase0(p, smem))
  RUNP(2, phase1(p, smem))
  RUNP(4, phase2(p, smem))
  RUNP(8, phase_res_gemm((const h16*)(ws + OFF_Y), LDY, 1280, (const h16*)(ws + OFF_WOA), p.x, nullptr, (h16*)(ws + OFF_X1H), (float*)(ws + OFF_SSQX1), smem))
  RUNP(16, phase4(p, smem))
  RUNP(32, phase5(p, smem))
  RUNP(64, phase6(p, smem))
  if (PHM & 128) phase_final(p, smem);
}

extern "C" void kernel_launch(void* const* d_in, const int* in_sizes, int n_in, void* d_out, int out_size, void* d_ws,
                              size_t ws_size, hipStream_t stream) {
  static int grid_blocks = 0;
  static int cus_s = 0;
  if (!grid_blocks) {
    int dev = 0, cus = 0;
    (void)hipGetDevice(&dev);
    (void)hipDeviceGetAttribute(&cus, hipDeviceAttributeMultiprocessorCount, dev);
    if (cus < 8) cus = 256;
    cus -= cus % 8;
    cus_s = cus;
    grid_blocks = cus * 2;
  }
  Params p{};
  const float** pp = (const float**)&p;
  for (int i = 0; i < 22; i++) pp[i] = (const float*)d_in[i];
  p.out = (float*)d_out;
  p.ws = (unsigned char*)d_ws;
  (void)hipMemsetAsync((unsigned char*)d_ws + OFF_BAR, 0, XCD_BAR_WORDS * sizeof(unsigned), stream);
  void* args[] = {&p};
  hipError_t e = hipLaunchCooperativeKernel((void*)yoco_fwd, dim3(grid_blocks), dim3(256), args, 0, stream);
  if (e != hipSuccess && grid_blocks != cus_s) {
    (void)hipGetLastError();
    grid_blocks = cus_s;
    e = hipLaunchCooperativeKernel((void*)yoco_fwd, dim3(grid_blocks), dim3(256), args, 0, stream);
  }
  if (e != hipSuccess) fprintf(stderr, "cooperative launch failed: %s (grid %d)\n", hipGetErrorString(e), grid_blocks);
}
```

```cpp
#include <hip/hip_runtime.h>
#include <hip/hip_cooperative_groups.h>
#include <cstdio>
namespace cg = cooperative_groups;

typedef _Float16 h16;
typedef __attribute__((ext_vector_type(8))) _Float16 h16x8;
typedef __attribute__((ext_vector_type(4))) _Float16 h16x4;
typedef __attribute__((ext_vector_type(16))) float f32x16;
typedef __attribute__((ext_vector_type(4))) unsigned u32x4;

#define DI __device__ __forceinline__
#define MFMA(a, b, c) __builtin_amdgcn_mfma_f32_32x32x16_f16((a), (b), (c), 0, 0, 0)

constexpr int M_TOK = 32768;
constexpr int SEQ = 2048;
constexpr size_t MiB = 1u << 20;
constexpr int LD1K = 1088;
constexpr int LDY = 1344;
constexpr int LDKV = 320;
constexpr size_t OFF_W1T = 0;
constexpr size_t OFF_WRG = 5 * MiB + 512 * 1024;
constexpr size_t OFF_WIG = 6 * MiB;
constexpr size_t OFF_WOA = 6 * MiB + 512 * 1024;
constexpr size_t OFF_W4T = 9 * MiB + 512 * 1024;
constexpr size_t OFF_W5KV = 13 * MiB + 512 * 1024;
constexpr size_t OFF_W5Q = 15 * MiB;
constexpr size_t OFF_WOB = 16 * MiB + 512 * 1024;
constexpr size_t OFF_COS = 19 * MiB;
constexpr size_t OFF_SIN = OFF_COS + 256 * 1024;
constexpr size_t OFF_SSQX1 = 19 * MiB + 512 * 1024;
constexpr size_t OFF_SSQKV = 21 * MiB + 512 * 1024;
constexpr size_t OFF_SSQQ = 22 * MiB;
constexpr size_t OFF_SSQO = 23 * MiB;
constexpr size_t OFF_BAR = 25 * MiB;
constexpr size_t SLOT1 = 26 * MiB;
constexpr size_t SLOT2 = 110 * MiB;
constexpr size_t SLOT3 = 270 * MiB;
constexpr size_t OFF_H0 = SLOT1, OFF_Y = SLOT1, OFF_CKV = SLOT1, OFF_CQ = SLOT1 + 24 * MiB, OFF_Y2 = SLOT1;
constexpr size_t OFF_XB = SLOT2, OFF_SG = SLOT2 + 80 * MiB, OFF_X1H = 436 * MiB  , OFF_Q = SLOT2, OFF_SG2 = SLOT2 + 96 * MiB;
constexpr size_t OFF_X2 = SLOT2;
constexpr size_t OFF_TAGS = 432 * MiB;
constexpr size_t OFF_KF = SLOT3  , OFF_KR = SLOT3 + 64 * MiB  , OFF_VT = SLOT3 + 96 * MiB;

struct Params {
  const float *x, *norm_a, *w_in_a, *conv_w, *conv_b, *w_rg, *b_rg, *w_ig, *b_ig, *lam, *w_out_a;
  const float *norm_kv, *w_dkv, *kv_norm, *w_uk, *w_uv, *norm_b, *w_in_b, *q_norm, *w_uq, *w_out_b, *final_norm;
  float* out;
  unsigned char* ws;
};

DI int crow(int i, int h) { return (i & 3) + 8 * (i >> 2) + 4 * h; }
DI constexpr int crow0(int i) { return (i & 3) + 8 * (i >> 2); }
DI float fexp2(float x) { return __builtin_amdgcn_exp2f(x); }
DI float frcp(float x) { return __builtin_amdgcn_rcpf(x); }
DI float silu_f(float v) { return v * frcp(1.f + fexp2(-1.44269504f * v)); }
DI float wave_sum(float v) {
#pragma unroll
  for (int o = 32; o; o >>= 1) v += __shfl_xor(v, o);
  return v;
}
DI float half_sum32(float v) {
#pragma unroll
  for (int o = 16; o; o >>= 1) v += __shfl_xor(v, o);
  return v;
}
DI int ptid() { int t = __builtin_amdgcn_workitem_id_x(); asm volatile("" : "+v"(t)); return t; }
DI float xhalf_max(float v) {
  typedef unsigned u32x2_t __attribute__((ext_vector_type(2)));
  const unsigned u = __float_as_uint(v);
  const u32x2_t rr = __builtin_amdgcn_permlane32_swap(u, u, false, false);
  return fmaxf(__uint_as_float(rr[0]), __uint_as_float(rr[1]));
}
DI int vblock() { return (blockIdx.x & 7) * (gridDim.x >> 3) + (blockIdx.x >> 3); }
DI int round_item(int k, int n) {
  const int G = gridDim.x, base = k * G;
  if (base + G <= n) return base + vblock();
  const int t = base + (int)blockIdx.x;
  return t < n ? t : -1;
}

DI void transpose_tile(const float* __restrict__ src, int ld, int n_off, h16* __restrict__ dst, int dst_ld, int row_off,
                       const float* __restrict__ gain, int tn, int tk, float* lds) {
  const int tid = ptid();
  const int k0 = tk * 64, n0 = tn * 64;
#pragma unroll
  for (int i = 0; i < 4; i++) {
    const int idx = tid + 256 * i, kk = idx >> 4, n4 = idx & 15;
    const float4 v = *(const float4*)(src + (size_t)(k0 + kk) * ld + n_off + n0 + n4 * 4);
    const float g = gain ? gain[k0 + kk] : 1.f;
    float* d = lds + kk * 65 + n4 * 4;
    d[0] = v.x * g; d[1] = v.y * g; d[2] = v.z * g; d[3] = v.w * g;
  }
  __syncthreads();
#pragma unroll
  for (int i = 0; i < 2; i++) {
    const int idx = tid + 256 * i, nn = idx >> 3, kc = idx & 7;
    h16x8 o;
#pragma unroll
    for (int j = 0; j < 8; j++) o[j] = (h16)lds[(kc * 8 + j) * 65 + nn];
    *(h16x8*)(dst + (size_t)(row_off + n0 + nn) * dst_ld + k0 + kc * 8) = o;
  }
  __syncthreads();
}

DI void phase0(const Params& p, unsigned char* smem) {
  float* lds = (float*)smem;
  unsigned char* ws = p.ws;
  const int tid = ptid(), lane = tid & 63;
  for (int t = blockIdx.x; t < 2000; t += gridDim.x) {
    int u = t;
    if (u < 640) { transpose_tile(p.w_in_a, 2560, 0, (h16*)(ws + OFF_W1T), LD1K, 0, nullptr, u % 40, u / 40, lds); continue; }
    u -= 640;
    if (u < 80) {
      const int which = u / 40, n = (u % 40) >> 2, tn = u & 1, tk = (u >> 1) & 1;
      transpose_tile((which ? p.w_ig : p.w_rg) + n * 16384, 128, 0, (h16*)(ws + (which ? OFF_WIG : OFF_WRG)), 128, n * 128, nullptr, tn, tk, lds);
      continue;
    }
    u -= 80;
    if (u < 320) { transpose_tile(p.w_out_a, 1024, 0, (h16*)(ws + OFF_WOA), LDY, 0, nullptr, u % 16, u / 16, lds); continue; }
    u -= 320;
    if (u < 64) { transpose_tile(p.w_dkv, 320, 0, (h16*)(ws + OFF_W4T), LD1K, 0, p.norm_kv, u % 4, u / 4, lds); continue; }
    u -= 64;
    if (u < 96) { transpose_tile(p.w_in_b, 1408, 0, (h16*)(ws + OFF_W4T), LD1K, 256, p.norm_b, u % 6, u / 6, lds); continue; }
    u -= 96;
    if (u < 256) { transpose_tile(p.w_in_b, 1408, 384, (h16*)(ws + OFF_W4T), LD1K, 640, p.norm_b, u % 16, u / 16, lds); continue; }
    u -= 256;
    if (u < 16) { transpose_tile(p.w_dkv, 320, 256, (h16*)(ws + OFF_W4T), LD1K, 1664, p.norm_kv, 0, u, lds); continue; }
    u -= 16;
    if (u < 64) { transpose_tile(p.w_uk, 1024, 0, (h16*)(ws + OFF_W5KV), LDKV, 0, p.kv_norm, u % 16, u / 16, lds); continue; }
    u -= 64;
    if (u < 64) { transpose_tile(p.w_uv, 1024, 0, (h16*)(ws + OFF_W5KV), LDKV, 1024, p.kv_norm, u % 16, u / 16, lds); continue; }
    u -= 64;
    if (u < 144) { transpose_tile(p.w_uq, 1536, 0, (h16*)(ws + OFF_W5Q), 384, 0, p.q_norm, u % 24, u / 24, lds); continue; }
    u -= 144;
    transpose_tile(p.w_out_b, 1024, 0, (h16*)(ws + OFF_WOB), LD1K, 0, nullptr, u % 16, u / 16, lds);
  }
  {
    u32x4* tz = (u32x4*)(ws + OFF_TAGS);
    for (int e = blockIdx.x * 256 + tid; e < M_TOK * 16 * 8 / 16; e += gridDim.x * 256) tz[e] = (u32x4){0u, 0u, 0u, 0u};
  }
  {
    h16* z = (h16*)(ws + OFF_W4T) + (size_t)1728 * LD1K;
    for (int e = blockIdx.x * 256 + tid; e < 64 * LD1K; e += gridDim.x * 256) z[e] = (h16)0.f;
  }
  {
    float* ct = (float*)(ws + OFF_COS);
    float* st = (float*)(ws + OFF_SIN);
    for (int e = blockIdx.x * 256 + tid; e < SEQ * 32; e += gridDim.x * 256) {
      const int pos = e >> 5, i = e & 31;
      const float inv = powf(10000.f, -(float)(2 * i) / 64.f);
      const float ang = (float)pos * inv;
      const double a = (double)ang;
      const double k = rint(a * 0.15915494309189535);
      const float rr = (float)(a - k * 6.283185307179586);
      ct[e] = cosf(rr);
      st[e] = sinf(rr);
    }
  }
  {
    h16* h0 = (h16*)(ws + OFF_H0);
    const int nwv = gridDim.x * 4;
    const int rpw = (((M_TOK + nwv - 1) / nwv) + 3) & ~3;
    const int rbase = (blockIdx.x * 4 + (tid >> 6)) * rpw;
    float4 g[4];
#pragma unroll
    for (int i = 0; i < 4; i++) g[i] = ((const float4*)p.norm_a)[lane + 64 * i];
    for (int k = 0; k < rpw && rbase + k < M_TOK; k += 4) {
      float4 v[4][4];
#pragma unroll
      for (int u = 0; u < 4; u++) {
        const float4* xr = (const float4*)(p.x + (size_t)(rbase + k + u) * 1024);
#pragma unroll
        for (int i = 0; i < 4; i++) v[u][i] = xr[lane + 64 * i];
      }
#pragma unroll
      for (int u = 0; u < 4; u++) {
        float ss = 0.f;
#pragma unroll
        for (int i = 0; i < 4; i++) ss += v[u][i].x * v[u][i].x + v[u][i].y * v[u][i].y + v[u][i].z * v[u][i].z + v[u][i].w * v[u][i].w;
        ss = wave_sum(ss);
        const float rinv = rsqrtf(ss * (1.f / 1024.f) + 1e-6f);
#pragma unroll
        for (int i = 0; i < 4; i++) {
          h16x4 o;
          o[0] = (h16)(v[u][i].x * rinv * g[i].x);
          o[1] = (h16)(v[u][i].y * rinv * g[i].y);
          o[2] = (h16)(v[u][i].z * rinv * g[i].z);
          o[3] = (h16)(v[u][i].w * rinv * g[i].w);
          *(h16x4*)(h0 + (size_t)(rbase + k + u) * LD1K + (lane + 64 * i) * 4) = o;
        }
      }
    }
  }
}

constexpr int LROW = 144;
constexpr int MI = 4;
constexpr int GEMM_LDS = 384 * LROW;
template <bool SWAP, bool PIN = false>
DI void gemm_mainloop(const h16* __restrict__ A, int lda, const h16* __restrict__ Bt, int ldb, int K, int m0, int n0,
                      unsigned char* smem, f32x16 (&acc)[MI][2], int kstart = 0) {
  const int tid = ptid(), lane = tid & 63, w = tid >> 6;
  const int r = lane & 31, h = lane >> 5;
  const int wm = w >> 1, wn = w & 1;
  const int seg = tid & 7, lrow = tid >> 3;
  const unsigned char* Ab = (const unsigned char*)(A + (size_t)m0 * lda);
  const unsigned char* Bb = (const unsigned char*)(Bt + (size_t)n0 * ldb);
  const unsigned offa0 = (unsigned)(lrow * lda + seg * 8) * 2u, offb0 = (unsigned)(lrow * ldb + seg * 8) * 2u;
  int kcur = kstart;
  unsigned offa = offa0 + (unsigned)kcur * 128u, offb = offb0 + (unsigned)kcur * 128u;
  u32x4 st[12];
#pragma unroll
  for (int i = 0; i < 8; i++) st[i] = *(const u32x4*)(Ab + (size_t)i * 64 * lda + offa);
#pragma unroll
  for (int i = 0; i < 4; i++) st[8 + i] = *(const u32x4*)(Bb + (size_t)i * 64 * ldb + offb);
#pragma unroll
  for (int mi = 0; mi < MI; mi++)
#pragma unroll
    for (int ni = 0; ni < 2; ni++)
#pragma unroll
      for (int i = 0; i < 16; i++) acc[mi][ni][i] = 0.f;
  const int nk = K >> 6;
  unsigned char* wA = smem + lrow * LROW + seg * 16;
  const unsigned char* rA = smem + (wm * 128 + r) * LROW + h * 16;
  const unsigned char* rB = smem + (256 + wn * 64 + r) * LROW + h * 16;
  for (int kt = 0; kt < nk; kt++) {
#pragma unroll
    for (int i = 0; i < 12; i++) *(u32x4*)(wA + i * 32 * LROW) = st[i];
    __syncthreads();
    if (kt + 1 < nk) {
      kcur = (kcur + 1 == nk) ? 0 : kcur + 1;
      offa = offa0 + (unsigned)kcur * 128u;
      offb = offb0 + (unsigned)kcur * 128u;
#pragma unroll
      for (int i = 0; i < 8; i++) st[i] = *(const u32x4*)(Ab + (size_t)i * 64 * lda + offa);
#pragma unroll
      for (int i = 0; i < 4; i++) st[8 + i] = *(const u32x4*)(Bb + (size_t)i * 64 * ldb + offb);
    }
    if (PIN) __builtin_amdgcn_sched_barrier(0);
#pragma unroll
    for (int ks = 0; ks < 4; ks++) {
      h16x8 af[MI], bf[2];
#pragma unroll
      for (int mi = 0; mi < MI; mi++) af[mi] = *(const h16x8*)(rA + mi * 32 * LROW + ks * 32);
      bf[0] = *(const h16x8*)(rB + ks * 32);
      bf[1] = *(const h16x8*)(rB + 32 * LROW + ks * 32);
#pragma unroll
      for (int mi = 0; mi < MI; mi++)
#pragma unroll
        for (int ni = 0; ni < 2; ni++)
          acc[mi][ni] = SWAP ? MFMA(bf[ni], af[mi], acc[mi][ni]) : MFMA(af[mi], bf[ni], acc[mi][ni]);
    }
    __syncthreads();
  }
}


constexpr int STG_ROW = 144;
constexpr int STG_WAVE = 64 * STG_ROW;
DI void stage_put(unsigned char* wl, int r, int h, int ni, int gi, h16x4 o) {
  *(h16x4*)(wl + r * STG_ROW + (ni * 32 + 8 * gi + 4 * h) * 2) = o;
}
DI void stage_fence() {
  __builtin_amdgcn_fence(__ATOMIC_ACQ_REL, "wavefront");
  __builtin_amdgcn_wave_barrier();
}
DI void stage_flush(const unsigned char* wl, int lane, h16* grow0, size_t ld) {
  stage_fence();
#pragma unroll
  for (int k = 0; k < 4; k++) {
    const int idx = lane + 64 * k, row = idx >> 3, seg = idx & 7;
    const u32x4 v = *(const u32x4*)(wl + row * STG_ROW + seg * 16);
    *(u32x4*)(grow0 + (size_t)row * ld + seg * 8) = v;
  }
  stage_fence();
}

DI void phase1(const Params& p, unsigned char* smem) {
  unsigned char* ws = p.ws;
  const h16* A = (const h16*)(ws + OFF_H0);
  const h16* Bt = (const h16*)(ws + OFF_W1T);
  h16* xb = (h16*)(ws + OFF_XB);
  h16* sg = (h16*)(ws + OFF_SG);
  const int lane = ptid() & 63, w = ptid() >> 6, r = lane & 31, h = lane >> 5, wm = w >> 1, wn = w & 1;
  for (int t = vblock(); t < 128 * 20; t += gridDim.x) {
    const int m0 = (t / 20) * 256, n0 = (t % 20) * 128;
    f32x16 acc[MI][2];
    const int nb = n0 + wn * 64;
    if (n0 >= 1280) {
      gemm_mainloop<false>(A, LD1K, Bt, LD1K, 1024, m0, n0, smem, acc, (t * 5) & 15);
#pragma unroll
      for (int mi = 0; mi < MI; mi++)
#pragma unroll
        for (int ni = 0; ni < 2; ni++) {
          const int tb = (m0 + wm * 128 + mi * 32) >> 5, cb = (nb - 1280 + ni * 32) >> 5;
          h16x8 v0, v1;
#pragma unroll
          for (int i = 0; i < 8; i++) {
            v0[i] = (h16)silu_f(acc[mi][ni][i]);
            v1[i] = (h16)silu_f(acc[mi][ni][8 + i]);
          }
          h16* d = sg + (((size_t)tb * 40 + cb) * 64 + lane) * 16;
          *(h16x8*)d = v0;
          *(h16x8*)(d + 8) = v1;
        }
    } else {
      gemm_mainloop<true>(A, LD1K, Bt, LD1K, 1024, m0, n0, smem, acc, (t * 5) & 15);
      unsigned char* wl = smem + w * STG_WAVE;
#pragma unroll
      for (int mi = 0; mi < MI; mi++) {
#pragma unroll
        for (int ni = 0; ni < 2; ni++)
#pragma unroll
          for (int gi = 0; gi < 4; gi++) {
            h16x4 o;
#pragma unroll
            for (int j = 0; j < 4; j++) o[j] = (h16)acc[mi][ni][gi * 4 + j];
            stage_put(wl, r, h, ni, gi, o);
          }
        stage_flush(wl, lane, xb + (size_t)(m0 + wm * 128 + mi * 32) * 1280 + nb, 1280);
      }
    }
    __syncthreads();
  }
}

DI void phase2(const Params& p, unsigned char* smem) {
  unsigned char* ws = p.ws;
  const h16* xb = (const h16*)(ws + OFF_XB);
  const h16* sg = (const h16*)(ws + OFF_SG);
  h16* y = (h16*)(ws + OFF_Y);
  const h16* Wrg = (const h16*)(ws + OFF_WRG);
  const h16* Wig = (const h16*)(ws + OFF_WIG);
  h16* As = (h16*)smem;
  h16* cw_s = (h16*)(smem + 34816);
  h16* cb_s = (h16*)(smem + 36864);
  float* agg = (float*)(smem + 37376);
  h16* Ys = (h16*)(smem + 38400);
  const int tid = ptid(), lane = tid & 63, w = tid >> 6, r = lane & 31, h = lane >> 5;
  const float L2E = 1.44269504f;
  for (int rk = 0; rk * (int)gridDim.x < 640; rk++) {
    const int it = round_item(rk, 640);
    if (it < 0) break;
    const int b = it / 40, n = (it % 40) >> 2, q = it & 3;
    __syncthreads();
    if (tid < 128) {
      cb_s[tid] = (h16)p.conv_b[n * 128 + tid];
#pragma unroll
      for (int k = 0; k < 4; k++) cw_s[k * 128 + tid] = (h16)p.conv_w[k * 1280 + n * 128 + tid];
    }
    h16x8 brg[8], big[8];
    {
      const h16* wr = Wrg + (size_t)(n * 128 + q * 32 + r) * 128 + h * 8;
      const h16* wi = Wig + (size_t)(n * 128 + q * 32 + r) * 128 + h * 8;
#pragma unroll
      for (int ks = 0; ks < 8; ks++) {
        brg[ks] = *(const h16x8*)(wr + ks * 16);
        big[ks] = *(const h16x8*)(wi + ks * 16);
      }
    }
    const int ch = n * 128 + q * 32 + r;
    const float cbr = -L2E * p.b_rg[ch], cbi = -L2E * p.b_ig[ch];
    const float cch2 = -8.f * L2E * log1pf(expf(-p.lam[ch]));
    float hc = 0.f;
    const int cgp = tid & 15, rgp = tid >> 4;
    const h16* src = xb + ((size_t)(b * SEQ) + rgp * 8 - 3) * 1280 + n * 128 + cgp * 8;
    u32x4 xin[11];
#pragma unroll
    for (int j = 0; j < 11; j++) {
      if (rgp == 0 && j < 3) xin[j] = (u32x4){0u, 0u, 0u, 0u};
      else xin[j] = *(const u32x4*)(src + (ptrdiff_t)j * 1280);
    }
    __syncthreads();
    for (int c = 0; c < 16; c++) {
      {
        const h16x8 w0 = *(const h16x8*)(cw_s + 0 * 128 + cgp * 8), w1 = *(const h16x8*)(cw_s + 1 * 128 + cgp * 8);
        const h16x8 w2 = *(const h16x8*)(cw_s + 2 * 128 + cgp * 8), w3 = *(const h16x8*)(cw_s + 3 * 128 + cgp * 8);
        const h16x8 bb = *(const h16x8*)(cb_s + cgp * 8);
#pragma unroll
        for (int o = 0; o < 8; o++) {
          h16x8 a = w0 * __builtin_bit_cast(h16x8, xin[o]) + bb;
          a = w1 * __builtin_bit_cast(h16x8, xin[o + 1]) + a;
          a = w2 * __builtin_bit_cast(h16x8, xin[o + 2]) + a;
          a = w3 * __builtin_bit_cast(h16x8, xin[o + 3]) + a;
          *(h16x8*)(As + (rgp * 8 + o) * 136 + cgp * 8) = a;
        }
      }
      __syncthreads();
      if (c + 1 < 16) {
        const h16* s2 = src + (size_t)(c + 1) * 128 * 1280;
#pragma unroll
        for (int j = 0; j < 11; j++) xin[j] = *(const u32x4*)(s2 + (ptrdiff_t)j * 1280);
      }
      __builtin_amdgcn_sched_barrier(0);
      const int tb = (b * SEQ + c * 128 + w * 32) >> 5, cbk = n * 4 + q;
      const h16* sgp = sg + (((size_t)tb * 40 + cbk) * 64 + lane) * 16;
      const h16x8 sg0 = *(const h16x8*)sgp, sg1 = *(const h16x8*)(sgp + 8);
      f32x16 ar, ai;
#pragma unroll
      for (int i = 0; i < 16; i++) { ar[i] = 0.f; ai[i] = 0.f; }
      {
        const unsigned char* rA = (const unsigned char*)As + (w * 32 + r) * 272 + h * 16;
#pragma unroll
        for (int ks = 0; ks < 8; ks++) {
          const h16x8 a = *(const h16x8*)(rA + ks * 32);
          ar = MFMA(a, brg[ks], ar);
          ai = MFMA(a, big[ks], ai);
        }
      }
      float P[16], H[16], SA[4], SB[4];
#pragma unroll
      for (int gi = 0; gi < 4; gi++) {
        float pp = 1.f, hh = 0.f;
#pragma unroll
        for (int j = 0; j < 4; j++) {
          const int i = gi * 4 + j;
          const int tok = w * 32 + 8 * gi + 4 * h + j;
          const float xc = (float)As[tok * 136 + q * 32 + r];
          const float a1 = fminf(fmaf(ar[i], -L2E, cbr), 60.f), a2 = fminf(fmaf(ai[i], -L2E, cbi), 60.f);
          const float t1 = 1.f + fexp2(a1), t2 = 1.f + fexp2(a2);
          const float inv = frcp(t1 * t2);
          const float rs = t2 * inv, is = t1 * inv;
          const float a = fexp2(cch2 * rs);
          const float om = fmaf(-a, a, 1.f);
          const float bt = __builtin_amdgcn_sqrtf(om) * is * xc;
          hh = a * hh + bt;
          pp = a * pp;
          P[i] = pp;
          H[i] = hh;
        }
        SA[gi] = pp;
        SB[gi] = hh;
      }
      float CA = 1.f, CB = 0.f, inA[4], inB[4];
#pragma unroll
      for (int gi = 0; gi < 4; gi++) {
        const float oa = __shfl_xor(SA[gi], 32), ob = __shfl_xor(SB[gi], 32);
        const float a0 = h ? oa : SA[gi], b0 = h ? ob : SB[gi];
        const float a1 = h ? SA[gi] : oa, b1 = h ? SB[gi] : ob;
        const float ca0 = CA, cb0 = CB;
        CB = a0 * CB + b0;
        CA = a0 * CA;
        inA[gi] = h ? CA : ca0;
        inB[gi] = h ? CB : cb0;
        CB = a1 * CB + b1;
        CA = a1 * CA;
      }
      if (h == 0) {
        agg[(w * 32 + r) * 2] = CA;
        agg[(w * 32 + r) * 2 + 1] = CB;
      }
      __syncthreads();
      float hin = hc, hrun = hc;
#pragma unroll
      for (int w2 = 0; w2 < 4; w2++) {
        const float a = agg[(w2 * 32 + r) * 2], bb = agg[(w2 * 32 + r) * 2 + 1];
        if (w2 == w) hin = hrun;
        hrun = a * hrun + bb;
      }
      hc = hrun;
#pragma unroll
      for (int gi = 0; gi < 4; gi++) {
        const float hs = inA[gi] * hin + inB[gi];
#pragma unroll
        for (int j = 0; j < 4; j++) {
          const int i = gi * 4 + j;
          const int tok = w * 32 + 8 * gi + 4 * h + j;
          const float hv = H[i] + P[i] * hs;
          const float g = (float)(i < 8 ? sg0[i & 7] : sg1[i & 7]);
          Ys[tok * 40 + r] = (h16)(hv * g);
        }
      }
      __syncthreads();
#pragma unroll
      for (int k = 0; k < 2; k++) {
        const int idx = tid + 256 * k, row = idx >> 2, seg = idx & 3;
        *(u32x4*)(y + ((size_t)(b * SEQ + c * 128 + row)) * LDY + n * 128 + q * 32 + seg * 8) = *(const u32x4*)(Ys + row * 40 + seg * 8);
      }
    }
  }
}

DI void phase_res_gemm(const h16* __restrict__ A, int ld, int K, const h16* __restrict__ Bt, const float* __restrict__ res, float* __restrict__ outp, h16* __restrict__ outh, float* __restrict__ ssq,
                       unsigned char* smem) {
  const int lane = ptid() & 63, w = ptid() >> 6, r = lane & 31, h = lane >> 5, wm = w >> 1, wn = w & 1;
  for (int t = vblock(); t < 128 * 8; t += gridDim.x) {
    const int m0 = (t >> 3) * 256, n0 = (t & 7) * 128;
    f32x16 acc[MI][2];
    gemm_mainloop<true>(A, ld, Bt, ld, K, m0, n0, smem, acc);
    const int nb = n0 + wn * 64;
    unsigned char* wl = smem + w * STG_WAVE;
#pragma unroll
    for (int mi = 0; mi < MI; mi++) {
      const int rowb = m0 + wm * 128 + mi * 32;
      const int row = rowb + r;
#pragma unroll
      for (int k = 0; k < 8; k++) {
        const int idx = lane + 64 * k, rr = idx >> 4, sg4 = idx & 15;
        *(float4*)(wl + rr * 272 + sg4 * 16) = *(const float4*)(res + (size_t)(rowb + rr) * 1024 + nb + sg4 * 4);
      }
      stage_fence();
      float sq = 0.f;
      h16x4 ov[2][4];
#pragma unroll
      for (int ni = 0; ni < 2; ni++)
#pragma unroll
        for (int gi = 0; gi < 4; gi++) {
          float4 v = *(const float4*)(wl + r * 272 + (ni * 32 + 8 * gi + 4 * h) * 4);
          v.x += acc[mi][ni][gi * 4 + 0];
          v.y += acc[mi][ni][gi * 4 + 1];
          v.z += acc[mi][ni][gi * 4 + 2];
          v.w += acc[mi][ni][gi * 4 + 3];
          if (outp) *(float4*)(outp + (size_t)row * 1024 + nb + 4 * h + ni * 32 + 8 * gi) = v;
          ov[ni][gi][0] = (h16)v.x; ov[ni][gi][1] = (h16)v.y; ov[ni][gi][2] = (h16)v.z; ov[ni][gi][3] = (h16)v.w;
          sq += v.x * v.x + v.y * v.y + v.z * v.z + v.w * v.w;
        }
      stage_fence();
#pragma unroll
      for (int ni = 0; ni < 2; ni++)
#pragma unroll
        for (int gi = 0; gi < 4; gi++) stage_put(wl, r, h, ni, gi, ov[ni][gi]);
      stage_flush(wl, lane, outh + (size_t)rowb * LD1K + nb, LD1K);
      sq += __shfl_xor(sq, 32);
      if (h == 0) ssq[(size_t)row * 16 + (nb >> 6)] = sq;
    }
    __syncthreads();
  }
}

DI void phase_final(const Params& p, unsigned char* smem) {
  unsigned char* ws = p.ws;
  const h16* A = (const h16*)(ws + OFF_Y2);
  const h16* Bt = (const h16*)(ws + OFF_WOB);
  const h16* __restrict__ res = (const h16*)(ws + OFF_X1H);
  unsigned long long* tags = (unsigned long long*)(ws + OFF_TAGS);
  const int lane = ptid() & 63, w = ptid() >> 6, r = lane & 31, h = lane >> 5, wm = w >> 1, wn = w & 1;
  for (int t = vblock(); t < 128 * 8; t += gridDim.x) {
    const int m0 = (t >> 3) * 256, n0 = (t & 7) * 128;
    f32x16 acc[MI][2];
    gemm_mainloop<true>(A, LD1K, Bt, LD1K, 1024, m0, n0, smem, acc);
    const int nb = n0 + wn * 64;
#pragma unroll
    for (int mi = 0; mi < MI; mi++) {
      const int row = m0 + wm * 128 + mi * 32 + r;
      float sq = 0.f;
      unsigned char* wlr = smem + w * STG_WAVE;
      {
        const h16* rsrc = res + (size_t)(m0 + wm * 128 + mi * 32) * LD1K + nb;
#pragma unroll
        for (int k = 0; k < 4; k++) {
          const int idx = lane + 64 * k, rr = idx >> 3, sg8 = idx & 7;
          *(u32x4*)(wlr + rr * STG_ROW + sg8 * 16) = *(const u32x4*)(rsrc + (size_t)rr * LD1K + sg8 * 8);
        }
        stage_fence();
      }
#pragma unroll
      for (int ni = 0; ni < 2; ni++)
#pragma unroll
        for (int gi = 0; gi < 4; gi++) {
          const h16x4 v = *(const h16x4*)(wlr + r * STG_ROW + (ni * 32 + 8 * gi + 4 * h) * 2);
#pragma unroll
          for (int j = 0; j < 4; j++) acc[mi][ni][gi * 4 + j] += (float)v[j];
#pragma unroll
          for (int j = 0; j < 4; j++) sq += acc[mi][ni][gi * 4 + j] * acc[mi][ni][gi * 4 + j];
        }
      stage_fence();
      sq += __shfl_xor(sq, 32);
      if (h == 0) {
        const unsigned long long pk = (unsigned long long)__float_as_uint(sq) | (1ull << 32);
        __hip_atomic_store(tags + (size_t)row * 16 + (nb >> 6), pk, __ATOMIC_RELAXED, __HIP_MEMORY_SCOPE_AGENT);
      }
    }
#pragma unroll
    for (int mi = 0; mi < MI; mi++) {
      const int row = m0 + wm * 128 + mi * 32 + r;
      float tot = 0.f;
#pragma unroll
      for (int k = 0; k < 8; k++) {
        unsigned long long* tp = tags + (size_t)row * 16 + 8 * h + k;
        unsigned long long v = __hip_atomic_load(tp, __ATOMIC_RELAXED, __HIP_MEMORY_SCOPE_AGENT);
        unsigned spin = 0;
        while ((unsigned)(v >> 32) != 1u && spin < (1u << 22)) {
          __builtin_amdgcn_s_sleep(1);
          v = __hip_atomic_load(tp, __ATOMIC_RELAXED, __HIP_MEMORY_SCOPE_AGENT);
          ++spin;
        }
        tot += __uint_as_float((unsigned)v);
      }
      tot += __shfl_xor(tot, 32);
      const float rinv = rsqrtf(tot * (1.f / 1024.f) + 1e-6f);
      unsigned char* wl = smem + w * STG_WAVE;
#pragma unroll
      for (int ni = 0; ni < 2; ni++)
#pragma unroll
        for (int gi = 0; gi < 4; gi++) {
          const float4 g = *(const float4*)(p.final_norm + nb + 4 * h + ni * 32 + 8 * gi);
          float4 o;
          o.x = acc[mi][ni][gi * 4 + 0] * rinv * g.x;
          o.y = acc[mi][ni][gi * 4 + 1] * rinv * g.y;
          o.z = acc[mi][ni][gi * 4 + 2] * rinv * g.z;
          o.w = acc[mi][ni][gi * 4 + 3] * rinv * g.w;
          *(float4*)(wl + r * 272 + (ni * 32 + 8 * gi + 4 * h) * 4) = o;
        }
      stage_fence();
      const int rowb = m0 + wm * 128 + mi * 32;
#pragma unroll
      for (int k = 0; k < 8; k++) {
        const int idx = lane + 64 * k, rr = idx >> 4, sg4 = idx & 15;
        *(float4*)(p.out + (size_t)(rowb + rr) * 1024 + nb + sg4 * 4) = *(const float4*)(wl + rr * 272 + sg4 * 16);
      }
      stage_fence();
    }
    __syncthreads();
  }
}

DI void phase4(const Params& p, unsigned char* smem) {
  unsigned char* ws = p.ws;
  const h16* A = (const h16*)(ws + OFF_X1H);
  const h16* Bt = (const h16*)(ws + OFF_W4T);
  const float* ssq = (const float*)(ws + OFF_SSQX1);
  h16* ckv = (h16*)(ws + OFF_CKV);
  h16* cq = (h16*)(ws + OFF_CQ);
  h16* sg2 = (h16*)(ws + OFF_SG2);
  h16* Kf = (h16*)(ws + OFF_KF);
  float* ssqkv = (float*)(ws + OFF_SSQKV);
  float* ssqq = (float*)(ws + OFF_SSQQ);
  const float* ct = (const float*)(ws + OFF_COS);
  const float* st = (const float*)(ws + OFF_SIN);
  float* rinv_s = (float*)(smem + GEMM_LDS);
  const int tid = ptid(), lane = tid & 63, w = tid >> 6, r = lane & 31, h = lane >> 5, wm = w >> 1, wn = w & 1;
  for (int base = 0; base < 128 * 14; base += gridDim.x) {
    const int t = base + ((base + (int)gridDim.x <= 128 * 14) ? vblock() : (int)blockIdx.x);
    if (t >= 128 * 14) break;
    const int m0 = (t / 14) * 256, n0 = (t % 14) * 128;
    {
      const float4* sp = (const float4*)(ssq + (size_t)(m0 + tid) * 16);
      float s = 0.f;
#pragma unroll
      for (int i = 0; i < 4; i++) { const float4 v = sp[i]; s += v.x + v.y + v.z + v.w; }
      rinv_s[tid] = rsqrtf(s * (1.f / 1024.f) + 1e-6f);
    }
    f32x16 acc[MI][2];
    gemm_mainloop<true>(A, LD1K, Bt, LD1K, 1024, m0, n0, smem, acc);
    const int nb = n0 + wn * 64;
    const int sub = nb >> 6;
    const int lr0 = wm * 128 + r;
    const int row0 = m0 + lr0;
    unsigned char* wl = smem + w * STG_WAVE;
    const int rowt = m0 + wm * 128;
    if (sub < 10) {
      const bool iskv = sub < 4;
      h16* gb = iskv ? ckv + (size_t)rowt * LDKV + nb : cq + (size_t)rowt * 384 + (nb - 256);
      const int ld = iskv ? LDKV : 384;
      float* sqb = iskv ? ssqkv + (size_t)row0 * 4 + sub : ssqq + (size_t)row0 * 8 + (sub - 4);
      const int sld = iskv ? 4 : 8;
#pragma unroll
      for (int mi = 0; mi < MI; mi++) {
        const float ri = rinv_s[lr0 + mi * 32];
        float sq = 0.f;
#pragma unroll
        for (int ni = 0; ni < 2; ni++)
#pragma unroll
          for (int gi = 0; gi < 4; gi++) {
            h16x4 o;
#pragma unroll
            for (int j = 0; j < 4; j++) {
              const float v = acc[mi][ni][gi * 4 + j] * ri;
              o[j] = (h16)v;
              sq += v * v;
            }
            stage_put(wl, r, h, ni, gi, o);
          }
        stage_flush(wl, lane, gb + (size_t)mi * 32 * ld, ld);
        sq += __shfl_xor(sq, 32);
        if (h == 0) sqb[mi * 32 * sld] = sq;
      }
    } else if (sub < 26) {
      h16* gb = sg2 + (size_t)rowt * 1024 + (nb - 640);
#pragma unroll
      for (int mi = 0; mi < MI; mi++) {
        const float ri = rinv_s[lr0 + mi * 32];
#pragma unroll
        for (int ni = 0; ni < 2; ni++)
#pragma unroll
          for (int gi = 0; gi < 4; gi++) {
            h16x4 o;
#pragma unroll
            for (int j = 0; j < 4; j++) o[j] = (h16)silu_f(acc[mi][ni][gi * 4 + j] * ri);
            stage_put(wl, r, h, ni, gi, o);
          }
        stage_flush(wl, lane, gb + (size_t)mi * 32 * 1024, 1024);
      }
    } else if (sub == 26) {
      const int b = m0 >> 11, s0 = (m0 & 2047) + lr0;
#pragma unroll
      for (int mi = 0; mi < MI; mi++) {
        const float ri = rinv_s[lr0 + mi * 32];
        const int s = s0 + mi * 32;
#pragma unroll
        for (int gi = 0; gi < 4; gi++) {
          const int j0 = 8 * gi + 4 * h;
          const float4 c = *(const float4*)(ct + s * 32 + j0);
          const float4 sn = *(const float4*)(st + s * 32 + j0);
          const float cc[4] = {c.x, c.y, c.z, c.w}, ss[4] = {sn.x, sn.y, sn.z, sn.w};
          h16x4 o1, o2;
#pragma unroll
          for (int j = 0; j < 4; j++) {
            const float x1 = acc[mi][0][gi * 4 + j] * ri, x2 = acc[mi][1][gi * 4 + j] * ri;
            o1[j] = (h16)(x1 * cc[j] - x2 * ss[j]);
            o2[j] = (h16)(x2 * cc[j] + x1 * ss[j]);
          }
          stage_put(wl, r, h, 0, gi, o1);
          stage_put(wl, r, h, 1, gi, o2);
        }
        stage_flush(wl, lane, (h16*)(ws + OFF_KR) + (size_t)(m0 + wm * 128 + mi * 32) * 64, 64);
      }
    }
    __syncthreads();
  }
}

template <bool ISQ>
DI void phase5_part(const Params& p, unsigned char* smem) {
  unsigned char* ws = p.ws;
  const h16* ckv = (const h16*)(ws + OFF_CKV);
  const h16* cq = (const h16*)(ws + OFF_CQ);
  const h16* Wkv = (const h16*)(ws + OFF_W5KV);
  const h16* Wq = (const h16*)(ws + OFF_W5Q);
  const float* ssqkv = (const float*)(ws + OFF_SSQKV);
  const float* ssqq = (const float*)(ws + OFF_SSQQ);
  h16* Kf = (h16*)(ws + OFF_KF);
  h16* Vt = (h16*)(ws + OFF_VT);
  h16* Q = (h16*)(ws + OFF_Q);
  const float* ct = (const float*)(ws + OFF_COS);
  const float* st = (const float*)(ws + OFF_SIN);
  float* rinv_s = (float*)(smem + GEMM_LDS);
  const int tid = ptid(), lane = tid & 63, w = tid >> 6, r = lane & 31, h = lane >> 5, wm = w >> 1, wn = w & 1;
  const float qscale = 0.07216878364870322f * 1.4426950408889634f;
  constexpr int NTT = ISQ ? 12 : 16;
  for (int t = vblock(); t < 128 * NTT; t += gridDim.x) {
    const int mt = t / NTT, nt = (t % NTT) + (ISQ ? 16 : 0);
    const int m0 = mt * 256;
    const int bb = m0 >> 11;
    const int lr0 = wm * 128 + 4 * h;
    const int s0 = (m0 & 2047) + lr0;
    f32x16 acc[MI][2];
    constexpr bool is_q = ISQ;
    const bool is_v = (nt >= 8) && !is_q;
    {
      float rv;
      if (!is_q) {
        const float4 v = *(const float4*)(ssqkv + (size_t)(m0 + tid) * 4);
        rv = rsqrtf((v.x + v.y + v.z + v.w) * (1.f / 256.f) + 1e-6f);
      } else {
        const float4* sp = (const float4*)(ssqq + (size_t)(m0 + tid) * 8);
        const float4 v0 = sp[0], v1 = sp[1];
        rv = rsqrtf((v0.x + v0.y + v0.z + v0.w + v1.x + v1.y) * (1.f / 384.f) + 1e-6f) * qscale;
      }
      rinv_s[tid] = rv;
    }
    const h16* Ap = is_q ? cq : ckv;
    const h16* Bp = is_q ? Wq : Wkv;
    constexpr int Kd = is_q ? 384 : 256;
    constexpr int ldk = is_q ? 384 : LDKV;
    const int n0 = is_q ? (nt - 16) * 128 : nt * 128;
    gemm_mainloop<true, false>(Ap, ldk, Bp, ldk, Kd, m0, n0, smem, acc);
    const int lrw = wm * 128 + r;
    const int sw = (m0 & 2047) + lrw;
    unsigned char* wl = smem + w * STG_WAVE;
    const int st0 = (m0 & 2047) + wm * 128;
    if (!is_v) {
      const int sub = (n0 >> 6) + wn;
      const int hd = is_q ? sub / 3 : nt;
      const int part = is_q ? sub % 3 : wn;
      const int ldo = is_q ? 192 : 128;
      h16* gb = (is_q ? Q : Kf) + ((size_t)(bb * 8 + hd) * SEQ + st0) * ldo + part * 64;
      if (!is_q || part < 2) {
#pragma unroll
        for (int mi = 0; mi < MI; mi++) {
          const float ri = rinv_s[lrw + mi * 32];
#pragma unroll
          for (int ni = 0; ni < 2; ni++)
#pragma unroll
            for (int gi = 0; gi < 4; gi++) {
              h16x4 o;
#pragma unroll
              for (int j = 0; j < 4; j++) o[j] = (h16)(acc[mi][ni][gi * 4 + j] * ri);
              stage_put(wl, r, h, ni, gi, o);
            }
          stage_flush(wl, lane, gb + (size_t)mi * 32 * ldo, ldo);
        }
      } else {
#pragma unroll
        for (int mi = 0; mi < MI; mi++) {
          const float ri = rinv_s[lrw + mi * 32];
          const int s = sw + mi * 32;
#pragma unroll
          for (int gi = 0; gi < 4; gi++) {
            const int j0 = 8 * gi + 4 * h;
            const float4 c = *(const float4*)(ct + s * 32 + j0);
            const float4 sn = *(const float4*)(st + s * 32 + j0);
            const float cc[4] = {c.x, c.y, c.z, c.w}, ss[4] = {sn.x, sn.y, sn.z, sn.w};
            h16x4 o1, o2;
#pragma unroll
            for (int j = 0; j < 4; j++) {
              const float x1 = acc[mi][0][gi * 4 + j] * ri, x2 = acc[mi][1][gi * 4 + j] * ri;
              o1[j] = (h16)(x1 * cc[j] - x2 * ss[j]);
              o2[j] = (h16)(x2 * cc[j] + x1 * ss[j]);
            }
            stage_put(wl, r, h, 0, gi, o1);
            stage_put(wl, r, h, 1, gi, o2);
          }
          stage_flush(wl, lane, gb + (size_t)mi * 32 * 192, 192);
        }
      }
    } else {
#pragma unroll
      for (int mp = 0; mp < 2; mp++) {
#pragma unroll
        for (int m2 = 0; m2 < 2; m2++) {
          const int mi = mp * 2 + m2;
          const float ri = rinv_s[lrw + mi * 32];
          const int t = m2 * 32 + r;
          const int pos = (t & ~15) + 8 * ((t >> 2) & 1) + 4 * ((t >> 3) & 1) + (t & 3);
#pragma unroll
          for (int ni = 0; ni < 2; ni++)
#pragma unroll
            for (int i = 0; i < 16; i++)
              *(h16*)(wl + (ni * 32 + crow(i, h)) * STG_ROW + pos * 2) = (h16)(acc[mi][ni][i] * ri);
        }
        stage_fence();
        const int kt = (st0 + mp * 64) >> 6;
        h16* gv = Vt + (((size_t)(bb * 8 + (nt - 8)) * 32 + kt) * 128 + wn * 64) * 64;
#pragma unroll
        for (int k = 0; k < 8; k++) {
          const int idx = lane + 64 * k, row = idx >> 3, seg = idx & 7;
          *(u32x4*)(gv + row * 64 + seg * 8) = *(const u32x4*)(wl + row * STG_ROW + seg * 16);
        }
        stage_fence();
      }
    }
    __syncthreads();
  }
}

DI void phase5(const Params& p, unsigned char* smem) {
  phase5_part<false>(p, smem);
  phase5_part<true>(p, smem);
}

constexpr int KROW = 400;
constexpr int VROW = 144;
DI void phase6(const Params& p, unsigned char* smem) {
  unsigned char* ws = p.ws;
  const h16* Q = (const h16*)(ws + OFF_Q);
  const h16* Kf = (const h16*)(ws + OFF_KF);
  const h16* Vt = (const h16*)(ws + OFF_VT);
  const h16* sg2 = (const h16*)(ws + OFF_SG2);
  h16* y2 = (h16*)(ws + OFF_Y2);
  unsigned char* Ks = smem;
  unsigned char* Vs = smem + 64 * KROW;
  const int tid = ptid(), lane = tid & 63, w = tid >> 6, r = lane & 31, h = lane >> 5;
  for (int it2 = vblock() * 2; it2 < 2048; it2 += gridDim.x * 2)
  for (int sel = 0; sel < 2; sel++) {
    const int bh = it2 >> 4, xx = (it2 >> 1) & 7;
    const int qb = sel ? xx : 15 - xx;
    const int b = bh >> 3, hd = bh & 7;
    const int qrow = qb * 128 + w * 32 + r;
    h16x8 qf[12];
    {
      const h16* qp = Q + ((size_t)bh * SEQ + qrow) * 192 + h * 8;
#pragma unroll
      for (int ks = 0; ks < 12; ks++) qf[ks] = *(const h16x8*)(qp + ks * 16);
    }
    f32x16 O[4];
#pragma unroll
    for (int dt = 0; dt < 4; dt++)
#pragma unroll
      for (int i = 0; i < 16; i++) O[dt][i] = 0.f;
    float m = -INFINITY, l = 0.f;
    const int nkt = 2 * qb + 2;
    const h16* kbase = Kf + (size_t)bh * SEQ * 128;
    const h16* rbase = (const h16*)(ws + OFF_KR) + (size_t)b * SEQ * 64;
    const h16* vbase = Vt + (size_t)bh * 128 * SEQ;
    u32x4 kst[6], vst[4];
    const h16* kg = kbase + (size_t)(tid >> 4) * 128 + (tid & 15) * 8;
    const h16* rg = rbase + (size_t)(tid >> 3) * 64 + (tid & 7) * 8;
    const h16* vg = vbase + (size_t)(tid >> 3) * 64 + (tid & 7) * 8;
    unsigned char* kw = Ks + (tid >> 4) * KROW + (tid & 15) * 16;
    unsigned char* rw = Ks + (tid >> 3) * KROW + 256 + (tid & 7) * 16;
    unsigned char* vw = Vs + (tid >> 3) * VROW + (tid & 7) * 16;
#pragma unroll
    for (int i = 0; i < 4; i++) kst[i] = *(const u32x4*)(kg + i * 16 * 128);
#pragma unroll
    for (int i = 0; i < 2; i++) kst[4 + i] = *(const u32x4*)(rg + i * 32 * 64);
#pragma unroll
    for (int i = 0; i < 4; i++) vst[i] = *(const u32x4*)(vg + (size_t)i * 32 * 64);
    for (int kt = 0; kt < nkt; kt++) {
#pragma unroll
      for (int i = 0; i < 4; i++) *(u32x4*)(kw + i * 16 * KROW) = kst[i];
#pragma unroll
      for (int i = 0; i < 2; i++) *(u32x4*)(rw + i * 32 * KROW) = kst[4 + i];
#pragma unroll
      for (int i = 0; i < 4; i++) *(u32x4*)(vw + i * 32 * VROW) = vst[i];
      __syncthreads();
      if (kt + 1 < nkt) {
        kg += 64 * 128;
        rg += 64 * 64;
        vg += 8192;
#pragma unroll
        for (int i = 0; i < 4; i++) kst[i] = *(const u32x4*)(kg + i * 16 * 128);
#pragma unroll
        for (int i = 0; i < 2; i++) kst[4 + i] = *(const u32x4*)(rg + i * 32 * 64);
#pragma unroll
        for (int i = 0; i < 4; i++) vst[i] = *(const u32x4*)(vg + (size_t)i * 32 * 64);
      }
#pragma unroll
      for (int half = 0; half < 2; half++) {
        const int sb = (kt - (nkt - 2)) * 2 + half;
        if (sb > w) continue;
        const bool first = (m == -INFINITY);
        const float m_eff = first ? 0.f : m;
        f32x16 sc;
#pragma unroll
        for (int i = 0; i < 16; i++) sc[i] = -m_eff;
        const unsigned char* kr = Ks + (half * 32 + r) * KROW + h * 16;
#pragma unroll
        for (int g = 0; g < 3; g++) {
          h16x8 kf[4];
#pragma unroll
          for (int j = 0; j < 4; j++) kf[j] = *(const h16x8*)(kr + (g * 4 + j) * 32);
#pragma unroll
          for (int j = 0; j < 4; j++) sc = MFMA(kf[j], qf[g * 4 + j], sc);
        }
        if (sb == w) {
#pragma unroll
          for (int i = 0; i < 16; i++)
            if (crow(i, h) > r) sc[i] = -INFINITY;
        }
        float mx = sc[0];
#pragma unroll
        for (int i = 1; i < 16; i++) mx = fmaxf(mx, sc[i]);
        mx = xhalf_max(mx);
        if (__builtin_amdgcn_ballot_w64(first || mx > 8.f) != 0ull) {
          const float d = first ? mx : fmaxf(mx, 0.f);
          const float alpha = first ? 0.f : fexp2(-d);
          m = m_eff + d;
          l *= alpha;
#pragma unroll
          for (int dt = 0; dt < 4; dt++)
#pragma unroll
            for (int i = 0; i < 16; i++) O[dt][i] *= alpha;
#pragma unroll
          for (int i = 0; i < 16; i++) sc[i] -= d;
        }
        float ls = 0.f;
#pragma unroll
        for (int i = 0; i < 16; i++) {
          sc[i] = fexp2(sc[i]);
          ls += sc[i];
        }
        l += ls;
        h16x8 pf0, pf1;
#pragma unroll
        for (int jj = 0; jj < 8; jj++) {
          pf0[jj] = (h16)sc[jj];
          pf1[jj] = (h16)sc[8 + jj];
        }
        const unsigned char* vr = Vs + r * VROW + h * 16 + half * 64;
#pragma unroll
        for (int dp = 0; dp < 2; dp++) {
          h16x8 vf[4];
#pragma unroll
          for (int j = 0; j < 4; j++) vf[j] = *(const h16x8*)(vr + (dp * 2 + (j >> 1)) * 32 * VROW + (j & 1) * 32);
#pragma unroll
          for (int j = 0; j < 4; j++) O[dp * 2 + (j >> 1)] = MFMA(vf[j], (j & 1) ? pf1 : pf0, O[dp * 2 + (j >> 1)]);
        }
      }
      __syncthreads();
    }
    l += __shfl_xor(l, 32);
    const float inv = 1.f / l;
    {
      unsigned char* wl = smem + w * STG_WAVE;
      const int rowb = b * SEQ + qb * 128 + w * 32;
#pragma unroll
      for (int dp = 0; dp < 2; dp++) {
        const h16* gsrc = sg2 + (size_t)rowb * 1024 + hd * 128 + dp * 64;
#pragma unroll
        for (int k = 0; k < 4; k++) {
          const int idx = lane + 64 * k, rr = idx >> 3, sg8 = idx & 7;
          *(u32x4*)(wl + rr * STG_ROW + sg8 * 16) = *(const u32x4*)(gsrc + (size_t)rr * 1024 + sg8 * 8);
        }
        stage_fence();
        h16x4 ov[2][4];
#pragma unroll
        for (int ni = 0; ni < 2; ni++)
#pragma unroll
          for (int gi = 0; gi < 4; gi++) {
            const h16x4 gt = *(const h16x4*)(wl + r * STG_ROW + (ni * 32 + 8 * gi + 4 * h) * 2);
#pragma unroll
            for (int jj = 0; jj < 4; jj++) ov[ni][gi][jj] = (h16)(O[dp * 2 + ni][gi * 4 + jj] * inv * (float)gt[jj]);
          }
        stage_fence();
#pragma unroll
        for (int ni = 0; ni < 2; ni++)
#pragma unroll
          for (int gi = 0; gi < 4; gi++) stage_put(wl, r, h, ni, gi, ov[ni][gi]);
        stage_flush(wl, lane, y2 + (size_t)rowb * LD1K + hd * 128 + dp * 64, LD1K);
      }
    }
    __syncthreads();
  }
}

DI void phase8(const Params& p) {
  const float* ssq = (const float*)(p.ws + OFF_SSQO);
  const int tid = ptid(), lane = tid & 63;
  const int nw = gridDim.x * 4;
  for (int row = blockIdx.x * 4 + (tid >> 6); row < M_TOK; row += nw) {
    const float4* sp = (const float4*)(ssq + (size_t)row * 16);
    float s = 0.f;
#pragma unroll
    for (int i = 0; i < 4; i++) { const float4 v = sp[i]; s += v.x + v.y + v.z + v.w; }
    const float rinv = rsqrtf(s * (1.f / 1024.f) + 1e-6f);
    const float4* xr = (const float4*)((const float*)(p.ws + OFF_X2) + (size_t)row * 1024);
    float4* orow = (float4*)(p.out + (size_t)row * 1024);
#pragma unroll
    for (int i = 0; i < 4; i++) {
      float4 v = xr[lane + 64 * i];
      const float4 g = ((const float4*)p.final_norm)[lane + 64 * i];
      v.x *= rinv * g.x; v.y *= rinv * g.y; v.z *= rinv * g.z; v.w *= rinv * g.w;
      orow[lane + 64 * i] = v;
    }
  }
}

#define XB_TMO      128
#define XB_XCNT(j)  (256  + 64 * (j))
#define XB_XSUB(j)  (1280 + 64 * (j))
#define XB_XGEN(j)  (2304 + 64 * (j))
#define XB_TOP      3328
#define XB_TOPGEN   3392
#define XCD_BAR_WORDS 3456
#define XB_SPIN_CAP (1u << 18)
#define LAS __attribute__((address_space(3)))
DI unsigned xb_ld(unsigned* p) { return __hip_atomic_load(p, __ATOMIC_RELAXED, __HIP_MEMORY_SCOPE_AGENT); }
DI unsigned xb_add(unsigned* p, unsigned v) { return __hip_atomic_fetch_add(p, v, __ATOMIC_RELAXED, __HIP_MEMORY_SCOPE_AGENT); }
DI unsigned xb_xcc_id() { return (unsigned)__builtin_amdgcn_s_getreg((3 << 11) | 20) & 0xFu; }
#define XB_SPIN(cond, bar) do { unsigned _sp = 0; while (cond) { __builtin_amdgcn_s_sleep(1); \
    if ((++_sp & 255u) == 0u) { if (xb_ld(&(bar)[XB_TMO])) break; if (_sp > XB_SPIN_CAP) { atomicAdd(&(bar)[XB_TMO], 1u); break; } } } } while (0)
struct XcdBarrier { unsigned* bar; unsigned x; volatile LAS unsigned* st; };
DI XcdBarrier xcd_barrier_post(unsigned* bar, volatile LAS unsigned* st) {
  XcdBarrier b; b.bar = bar; b.x = xb_xcc_id(); b.st = st;
  if (threadIdx.x == 0) (void)xb_add(&bar[XB_XCNT(b.x)], 1u);
  return b;
}
DI void xcd_barrier_complete(unsigned* bar, unsigned x, unsigned& nloc, unsigned& nx) {
  const unsigned G = gridDim.x;
  unsigned sum, cnt, mine, sp = 0u;
  for (;;) {
    sum = 0u; cnt = 0u; mine = 0u;
#pragma unroll
    for (unsigned j = 0; j < 16; ++j) { const unsigned c = xb_ld(&bar[XB_XCNT(j)]); sum += c; cnt += (c > 0u) ? 1u : 0u; mine = (j == x) ? c : mine; }
    if (sum == G) break;
    __builtin_amdgcn_s_sleep(1);
    if ((++sp & 255u) == 0u) { if (xb_ld(&bar[XB_TMO])) break; if (sp > XB_SPIN_CAP) { atomicAdd(&bar[XB_TMO], 1u); break; } }
  }
  nloc = mine > 0u ? mine : 1u; nx = cnt > 0u ? cnt : 1u;
}
DI void xcd_barrier(const XcdBarrier& b) {
  asm volatile("s_waitcnt vmcnt(0)" ::: "memory");
  __syncthreads();
  if (threadIdx.x == 0) {
    unsigned* bar = b.bar;
    __builtin_amdgcn_s_waitcnt(0);
    unsigned nloc = b.st[0], nx = b.st[1];
    if (nloc == 0u) { xcd_barrier_complete(bar, b.x, nloc, nx); b.st[0] = nloc; b.st[1] = nx; }
    const unsigned old = xb_add(&bar[XB_XSUB(b.x)], 1u);
    const unsigned gen = old / nloc;
    if (old + 1u == (gen + 1u) * nloc) {
      __builtin_amdgcn_fence(__ATOMIC_RELEASE, "agent");
      asm volatile("s_waitcnt vmcnt(0)" ::: "memory");
      const unsigned og = xb_add(&bar[XB_TOP], 1u);
      const unsigned tg = og / nx;
      if (og + 1u == (tg + 1u) * nx) xb_add(&bar[XB_TOPGEN], 1u);
      else XB_SPIN(xb_ld(&bar[XB_TOPGEN]) == tg, bar);
      __builtin_amdgcn_fence(__ATOMIC_ACQUIRE, "agent");
      xb_add(&bar[XB_XGEN(b.x)], 1u);
      asm volatile("s_waitcnt vmcnt(0)" ::: "memory");
    } else {
      XB_SPIN(xb_ld(&bar[XB_XGEN(b.x)]) == gen, bar);
      __builtin_amdgcn_fence(__ATOMIC_ACQUIRE, "agent");
      asm volatile("s_waitcnt vmcnt(0)" ::: "memory");
    }
  }
  __syncthreads();
}

constexpr int SMEM_BYTES = 56320;
__global__ void __launch_bounds__(256, 2) yoco_fwd(Params p) {
  __shared__ __attribute__((aligned(16))) unsigned char smem[SMEM_BYTES];
  __shared__ uint4 xb_words;
  unsigned char* ws = p.ws;
  if (threadIdx.x == 0) xb_words = make_uint4(0u, 0u, 0u, 0u);
  __syncthreads();
  const XcdBarrier xb = xcd_barrier_post((unsigned*)(ws + OFF_BAR), (volatile LAS unsigned*)&xb_words);
  if (p.out == nullptr) {
    const unsigned long long mg = *(const volatile unsigned long long*)((const char*)__builtin_amdgcn_implicitarg_ptr() + 88);
    if (mg == 1ull) ((volatile unsigned*)(ws + OFF_BAR))[XB_TMO] = 1u;
  }
#ifndef DUP
#define DUP 0
#endif
#ifndef PHM
#define PHM 0xfff
#endif
#define RUNP(bit, call) { if (PHM & bit) { call; } xcd_barrier(xb); if (DUP & bit) { call; xcd_barrier(xb); } }
  RUNP(1, phase0(p, smem))
  RUNP(2, phase1(p, smem))
  RUNP(4, phase2(p, smem))
  RUNP(8, phase_res_gemm((const h16*)(ws + OFF_Y), LDY, 1280, (const h16*)(ws + OFF_WOA), p.x, nullptr, (h16*)(ws + OFF_X1H), (float*)(ws + OFF_SSQX1), smem))
  RUNP(16, phase4(p, smem))
  RUNP(32, phase5(p, smem))
  RUNP(64, phase6(p, smem))
  if (PHM & 128) phase_final(p, smem);
}

extern "C" void kernel_launch(void* const* d_in, const int* in_sizes, int n_in, void* d_out, int out_size, void* d_ws,
                              size_t ws_size, hipStream_t stream) {
  static int grid_blocks = 0;
  static int cus_s = 0;
  if (!grid_blocks) {
    int dev = 0, cus = 0;
    (void)hipGetDevice(&dev);
    (void)hipDeviceGetAttribute(&cus, hipDeviceAttributeMultiprocessorCount, dev);
    if (cus < 8) cus = 256;
    cus -= cus % 8;
    cus_s = cus;
    grid_blocks = cus * 2;
  }
  Params p{};
  const float** pp = (const float**)&p;
  for (int i = 0; i < 22; i++) pp[i] = (const float*)d_in[i];
  p.out = (float*)d_out;
  p.ws = (unsigned char*)d_ws;
  (void)hipMemsetAsync((unsigned char*)d_ws + OFF_BAR, 0, XCD_BAR_WORDS * sizeof(unsigned), stream);
  void* args[] = {&p};
  hipError_t e = hipLaunchCooperativeKernel((void*)yoco_fwd, dim3(grid_blocks), dim3(256), args, 0, stream);
  if (e != hipSuccess && grid_blocks != cus_s) {
    (void)hipGetLastError();
    grid_blocks = cus_s;
    e = hipLaunchCooperativeKernel((void*)yoco_fwd, dim3(grid_blocks), dim3(256), args, 0, stream);
  }
  if (e != hipSuccess) fprintf(stderr, "cooperative launch failed: %s (grid %d)\n", hipGetErrorString(e), grid_blocks);
}
```

```cpp
#include <hip/hip_runtime.h>
#include <hip/hip_cooperative_groups.h>
#include <cstdio>
namespace cg = cooperative_groups;

typedef _Float16 h16;
typedef __attribute__((ext_vector_type(8))) _Float16 h16x8;
typedef __attribute__((ext_vector_type(4))) _Float16 h16x4;
typedef __attribute__((ext_vector_type(16))) float f32x16;
typedef __attribute__((ext_vector_type(4))) unsigned u32x4;

#define DI __device__ __forceinline__
#define MFMA(a, b, c) __builtin_amdgcn_mfma_f32_32x32x16_f16((a), (b), (c), 0, 0, 0)

constexpr int M_TOK = 32768;
constexpr int SEQ = 2048;
constexpr size_t MiB = 1u << 20;
constexpr int LD1K = 1088;
constexpr int LDY = 1344;
constexpr int LDKV = 320;
constexpr size_t OFF_W1T = 0;
constexpr size_t OFF_WRG = 5 * MiB + 512 * 1024;
constexpr size_t OFF_WIG = 6 * MiB;
constexpr size_t OFF_WOA = 6 * MiB + 512 * 1024;
constexpr size_t OFF_W4T = 9 * MiB + 512 * 1024;
constexpr size_t OFF_W5KV = 13 * MiB + 512 * 1024;
constexpr size_t OFF_W5Q = 15 * MiB;
constexpr size_t OFF_WOB = 16 * MiB + 512 * 1024;
constexpr size_t OFF_COS = 19 * MiB;
constexpr size_t OFF_SIN = OFF_COS + 256 * 1024;
constexpr size_t OFF_SSQX1 = 19 * MiB + 512 * 1024;
constexpr size_t OFF_SSQKV = 21 * MiB + 512 * 1024;
constexpr size_t OFF_SSQQ = 22 * MiB;
constexpr size_t OFF_SSQO = 23 * MiB;
constexpr size_t OFF_BAR = 25 * MiB;
constexpr size_t SLOT1 = 26 * MiB;
constexpr size_t SLOT2 = 110 * MiB;
constexpr size_t SLOT3 = 270 * MiB;
constexpr size_t OFF_H0 = SLOT1, OFF_Y = SLOT1, OFF_CKV = SLOT1, OFF_CQ = SLOT1 + 24 * MiB, OFF_Y2 = SLOT1;
constexpr size_t OFF_XB = SLOT2, OFF_SG = SLOT2 + 80 * MiB, OFF_X1H = 436 * MiB  , OFF_Q = SLOT2, OFF_SG2 = SLOT2 + 96 * MiB;
constexpr size_t OFF_X2 = SLOT2;
constexpr size_t OFF_TAGS = 432 * MiB;
constexpr size_t OFF_KF = SLOT3  , OFF_KR = SLOT3 + 64 * MiB  , OFF_VT = SLOT3 + 96 * MiB;

struct Params {
  const float *x, *norm_a, *w_in_a, *conv_w, *conv_b, *w_rg, *b_rg, *w_ig, *b_ig, *lam, *w_out_a;
  const float *norm_kv, *w_dkv, *kv_norm, *w_uk, *w_uv, *norm_b, *w_in_b, *q_norm, *w_uq, *w_out_b, *final_norm;
  float* out;
  unsigned char* ws;
};

DI int crow(int i, int h) { return (i & 3) + 8 * (i >> 2) + 4 * h; }
DI constexpr int crow0(int i) { return (i & 3) + 8 * (i >> 2); }
DI float fexp2(float x) { return __builtin_amdgcn_exp2f(x); }
DI float frcp(float x) { return __builtin_amdgcn_rcpf(x); }
DI float silu_f(float v) { return v * frcp(1.f + fexp2(-1.44269504f * v)); }
DI float wave_sum(float v) {
#pragma unroll
  for (int o = 32; o; o >>= 1) v += __shfl_xor(v, o);
  return v;
}
DI float half_sum32(float v) {
#pragma unroll
  for (int o = 16; o; o >>= 1) v += __shfl_xor(v, o);
  return v;
}
DI int ptid() { int t = __builtin_amdgcn_workitem_id_x(); asm volatile("" : "+v"(t)); return t; }
DI float xhalf_max(float v) {
  typedef unsigned u32x2_t __attribute__((ext_vector_type(2)));
  const unsigned u = __float_as_uint(v);
  const u32x2_t rr = __builtin_amdgcn_permlane32_swap(u, u, false, false);
  return fmaxf(__uint_as_float(rr[0]), __uint_as_float(rr[1]));
}
DI int vblock() { return (blockIdx.x & 7) * (gridDim.x >> 3) + (blockIdx.x >> 3); }
DI int round_item(int k, int n) {
  const int G = gridDim.x, base = k * G;
  if (base + G <= n) return base + vblock();
  const int t = base + (int)blockIdx.x;
  return t < n ? t : -1;
}

DI void transpose_tile(const float* __restrict__ src, int ld, int n_off, h16* __restrict__ dst, int dst_ld, int row_off,
                       const float* __restrict__ gain, int tn, int tk, float* lds) {
  const int tid = ptid();
  const int k0 = tk * 64, n0 = tn * 64;
#pragma unroll
  for (int i = 0; i < 4; i++) {
    const int idx = tid + 256 * i, kk = idx >> 4, n4 = idx & 15;
    const float4 v = *(const float4*)(src + (size_t)(k0 + kk) * ld + n_off + n0 + n4 * 4);
    const float g = gain ? gain[k0 + kk] : 1.f;
    float* d = lds + kk * 65 + n4 * 4;
    d[0] = v.x * g; d[1] = v.y * g; d[2] = v.z * g; d[3] = v.w * g;
  }
  __syncthreads();
#pragma unroll
  for (int i = 0; i < 2; i++) {
    const int idx = tid + 256 * i, nn = idx >> 3, kc = idx & 7;
    h16x8 o;
#pragma unroll
    for (int j = 0; j < 8; j++) o[j] = (h16)lds[(kc * 8 + j) * 65 + nn];
    *(h16x8*)(dst + (size_t)(row_off + n0 + nn) * dst_ld + k0 + kc * 8) = o;
  }
  __syncthreads();
}

DI void phase0(const Params& p, unsigned char* smem) {
  float* lds = (float*)smem;
  unsigned char* ws = p.ws;
  const int tid = ptid(), lane = tid & 63;
  for (int t = blockIdx.x; t < 2000; t += gridDim.x) {
    int u = t;
    if (u < 640) { transpose_tile(p.w_in_a, 2560, 0, (h16*)(ws + OFF_W1T), LD1K, 0, nullptr, u % 40, u / 40, lds); continue; }
    u -= 640;
    if (u < 80) {
      const int which = u / 40, n = (u % 40) >> 2, tn = u & 1, tk = (u >> 1) & 1;
      transpose_tile((which ? p.w_ig : p.w_rg) + n * 16384, 128, 0, (h16*)(ws + (which ? OFF_WIG : OFF_WRG)), 128, n * 128, nullptr, tn, tk, lds);
      continue;
    }
    u -= 80;
    if (u < 320) { transpose_tile(p.w_out_a, 1024, 0, (h16*)(ws + OFF_WOA), LDY, 0, nullptr, u % 16, u / 16, lds); continue; }
    u -= 320;
    if (u < 64) { transpose_tile(p.w_dkv, 320, 0, (h16*)(ws + OFF_W4T), LD1K, 0, p.norm_kv, u % 4, u / 4, lds); continue; }
    u -= 64;
    if (u < 96) { transpose_tile(p.w_in_b, 1408, 0, (h16*)(ws + OFF_W4T), LD1K, 256, p.norm_b, u % 6, u / 6, lds); continue; }
    u -= 96;
    if (u < 256) { transpose_tile(p.w_in_b, 1408, 384, (h16*)(ws + OFF_W4T), LD1K, 640, p.norm_b, u % 16, u / 16, lds); continue; }
    u -= 256;
    if (u < 16) { transpose_tile(p.w_dkv, 320, 256, (h16*)(ws + OFF_W4T), LD1K, 1664, p.norm_kv, 0, u, lds); continue; }
    u -= 16;
    if (u < 64) { transpose_tile(p.w_uk, 1024, 0, (h16*)(ws + OFF_W5KV), LDKV, 0, p.kv_norm, u % 16, u / 16, lds); continue; }
    u -= 64;
    if (u < 64) { transpose_tile(p.w_uv, 1024, 0, (h16*)(ws + OFF_W5KV), LDKV, 1024, p.kv_norm, u % 16, u / 16, lds); continue; }
    u -= 64;
    if (u < 144) { transpose_tile(p.w_uq, 1536, 0, (h16*)(ws + OFF_W5Q), 384, 0, p.q_norm, u % 24, u / 24, lds); continue; }
    u -= 144;
    transpose_tile(p.w_out_b, 1024, 0, (h16*)(ws + OFF_WOB), LD1K, 0, nullptr, u % 16, u / 16, lds);
  }
  {
    u32x4* tz = (u32x4*)(ws + OFF_TAGS);
    for (int e = blockIdx.x * 256 + tid; e < M_TOK * 16 * 8 / 16; e += gridDim.x * 256) tz[e] = (u32x4){0u, 0u, 0u, 0u};
  }
  {
    h16* z = (h16*)(ws + OFF_W4T) + (size_t)1728 * LD1K;
    for (int e = blockIdx.x * 256 + tid; e < 64 * LD1K; e += gridDim.x * 256) z[e] = (h16)0.f;
  }
  {
    float* ct = (float*)(ws + OFF_COS);
    float* st = (float*)(ws + OFF_SIN);
    for (int e = blockIdx.x * 256 + tid; e < SEQ * 32; e += gridDim.x * 256) {
      const int pos = e >> 5, i = e & 31;
      const float inv = powf(10000.f, -(float)(2 * i) / 64.f);
      const float ang = (float)pos * inv;
      const double a = (double)ang;
      const double k = rint(a * 0.15915494309189535);
      const float rr = (float)(a - k * 6.283185307179586);
      ct[e] = cosf(rr);
      st[e] = sinf(rr);
    }
  }
  {
    h16* h0 = (h16*)(ws + OFF_H0);
    const int nwv = gridDim.x * 4;
    const int rpw = (((M_TOK + nwv - 1) / nwv) + 3) & ~3;
    const int rbase = (blockIdx.x * 4 + (tid >> 6)) * rpw;
    float4 g[4];
#pragma unroll
    for (int i = 0; i < 4; i++) g[i] = ((const float4*)p.norm_a)[lane + 64 * i];
    for (int k = 0; k < rpw && rbase + k < M_TOK; k += 4) {
      float4 v[4][4];
#pragma unroll
      for (int u = 0; u < 4; u++) {
        const float4* xr = (const float4*)(p.x + (size_t)(rbase + k + u) * 1024);
#pragma unroll
        for (int i = 0; i < 4; i++) v[u][i] = xr[lane + 64 * i];
      }
#pragma unroll
      for (int u = 0; u < 4; u++) {
        float ss = 0.f;
#pragma unroll
        for (int i = 0; i < 4; i++) ss += v[u][i].x * v[u][i].x + v[u][i].y * v[u][i].y + v[u][i].z * v[u][i].z + v[u][i].w * v[u][i].w;
        ss = wave_sum(ss);
        const float rinv = rsqrtf(ss * (1.f / 1024.f) + 1e-6f);
#pragma unroll
        for (int i = 0; i < 4; i++) {
          h16x4 o;
          o[0] = (h16)(v[u][i].x * rinv * g[i].x);
          o[1] = (h16)(v[u][i].y * rinv * g[i].y);
          o[2] = (h16)(v[u][i].z * rinv * g[i].z);
          o[3] = (h16)(v[u][i].w * rinv * g[i].w);
          *(h16x4*)(h0 + (size_t)(rbase + k + u) * LD1K + (lane + 64 * i) * 4) = o;
        }
      }
    }
  }
}

constexpr int LROW = 144;
constexpr int MI = 4;
constexpr int GEMM_LDS = 384 * LROW;
template <bool SWAP, bool PIN = false>
DI void gemm_mainloop(const h16* __restrict__ A, int lda, const h16* __restrict__ Bt, int ldb, int K, int m0, int n0,
                      unsigned char* smem, f32x16 (&acc)[MI][2], int kstart = 0) {
  const int tid = ptid(), lane = tid & 63, w = tid >> 6;
  const int r = lane & 31, h = lane >> 5;
  const int wm = w >> 1, wn = w & 1;
  const int seg = tid & 7, lrow = tid >> 3;
  const unsigned char* Ab = (const unsigned char*)(A + (size_t)m0 * lda);
  const unsigned char* Bb = (const unsigned char*)(Bt + (size_t)n0 * ldb);
  const unsigned offa0 = (unsigned)(lrow * lda + seg * 8) * 2u, offb0 = (unsigned)(lrow * ldb + seg * 8) * 2u;
  int kcur = kstart;
  unsigned offa = offa0 + (unsigned)kcur * 128u, offb = offb0 + (unsigned)kcur * 128u;
  u32x4 st[12];
#pragma unroll
  for (int i = 0; i < 8; i++) st[i] = *(const u32x4*)(Ab + (size_t)i * 64 * lda + offa);
#pragma unroll
  for (int i = 0; i < 4; i++) st[8 + i] = *(const u32x4*)(Bb + (size_t)i * 64 * ldb + offb);
#pragma unroll
  for (int mi = 0; mi < MI; mi++)
#pragma unroll
    for (int ni = 0; ni < 2; ni++)
#pragma unroll
      for (int i = 0; i < 16; i++) acc[mi][ni][i] = 0.f;
  const int nk = K >> 6;
  unsigned char* wA = smem + lrow * LROW + seg * 16;
  const unsigned char* rA = smem + (wm * 128 + r) * LROW + h * 16;
  const unsigned char* rB = smem + (256 + wn * 64 + r) * LROW + h * 16;
  for (int kt = 0; kt < nk; kt++) {
#pragma unroll
    for (int i = 0; i < 12; i++) *(u32x4*)(wA + i * 32 * LROW) = st[i];
    __syncthreads();
    if (kt + 1 < nk) {
      kcur = (kcur + 1 == nk) ? 0 : kcur + 1;
      offa = offa0 + (unsigned)kcur * 128u;
      offb = offb0 + (unsigned)kcur * 128u;
#pragma unroll
      for (int i = 0; i < 8; i++) st[i] = *(const u32x4*)(Ab + (size_t)i * 64 * lda + offa);
#pragma unroll
      for (int i = 0; i < 4; i++) st[8 + i] = *(const u32x4*)(Bb + (size_t)i * 64 * ldb + offb);
    }
    if (PIN) __builtin_amdgcn_sched_barrier(0);
#pragma unroll
    for (int ks = 0; ks < 4; ks++) {
      h16x8 af[MI], bf[2];
#pragma unroll
      for (int mi = 0; mi < MI; mi++) af[mi] = *(const h16x8*)(rA + mi * 32 * LROW + ks * 32);
      bf[0] = *(const h16x8*)(rB + ks * 32);
      bf[1] = *(const h16x8*)(rB + 32 * LROW + ks * 32);
#pragma unroll
      for (int mi = 0; mi < MI; mi++)
#pragma unroll
        for (int ni = 0; ni < 2; ni++)
          acc[mi][ni] = SWAP ? MFMA(bf[ni], af[mi], acc[mi][ni]) : MFMA(af[mi], bf[ni], acc[mi][ni]);
    }
    __syncthreads();
  }
}


constexpr int STG_ROW = 144;
constexpr int STG_WAVE = 64 * STG_ROW;
DI void stage_put(unsigned char* wl, int r, int h, int ni, int gi, h16x4 o) {
  *(h16x4*)(wl + r * STG_ROW + (ni * 32 + 8 * gi + 4 * h) * 2) = o;
}
DI void stage_fence() {
  __builtin_amdgcn_fence(__ATOMIC_ACQ_REL, "wavefront");
  __builtin_amdgcn_wave_barrier();
}
DI void stage_flush(const unsigned char* wl, int lane, h16* grow0, size_t ld) {
  stage_fence();
#pragma unroll
  for (int k = 0; k < 4; k++) {
    const int idx = lane + 64 * k, row = idx >> 3, seg = idx & 7;
    const u32x4 v = *(const u32x4*)(wl + row * STG_ROW + seg * 16);
    *(u32x4*)(grow0 + (size_t)row * ld + seg * 8) = v;
  }
  stage_fence();
}

DI void phase1(const Params& p, unsigned char* smem) {
  unsigned char* ws = p.ws;
  const h16* A = (const h16*)(ws + OFF_H0);
  const h16* Bt = (const h16*)(ws + OFF_W1T);
  h16* xb = (h16*)(ws + OFF_XB);
  h16* sg = (h16*)(ws + OFF_SG);
  const int lane = ptid() & 63, w = ptid() >> 6, r = lane & 31, h = lane >> 5, wm = w >> 1, wn = w & 1;
  for (int t = vblock(); t < 128 * 20; t += gridDim.x) {
    const int m0 = (t / 20) * 256, n0 = (t % 20) * 128;
    f32x16 acc[MI][2];
    const int nb = n0 + wn * 64;
    if (n0 >= 1280) {
      gemm_mainloop<false>(A, LD1K, Bt, LD1K, 1024, m0, n0, smem, acc);
#pragma unroll
      for (int mi = 0; mi < MI; mi++)
#pragma unroll
        for (int ni = 0; ni < 2; ni++) {
          const int tb = (m0 + wm * 128 + mi * 32) >> 5, cb = (nb - 1280 + ni * 32) >> 5;
          h16x8 v0, v1;
#pragma unroll
          for (int i = 0; i < 8; i++) {
            v0[i] = (h16)silu_f(acc[mi][ni][i]);
            v1[i] = (h16)silu_f(acc[mi][ni][8 + i]);
          }
          h16* d = sg + (((size_t)tb * 40 + cb) * 64 + lane) * 16;
          *(h16x8*)d = v0;
          *(h16x8*)(d + 8) = v1;
        }
    } else {
      gemm_mainloop<true>(A, LD1K, Bt, LD1K, 1024, m0, n0, smem, acc);
      unsigned char* wl = smem + w * STG_WAVE;
#pragma unroll
      for (int mi = 0; mi < MI; mi++) {
#pragma unroll
        for (int ni = 0; ni < 2; ni++)
#pragma unroll
          for (int gi = 0; gi < 4; gi++) {
            h16x4 o;
#pragma unroll
            for (int j = 0; j < 4; j++) o[j] = (h16)acc[mi][ni][gi * 4 + j];
            stage_put(wl, r, h, ni, gi, o);
          }
        stage_flush(wl, lane, xb + (size_t)(m0 + wm * 128 + mi * 32) * 1280 + nb, 1280);
      }
    }
    __syncthreads();
  }
}

DI void phase2(const Params& p, unsigned char* smem) {
  unsigned char* ws = p.ws;
  const h16* xb = (const h16*)(ws + OFF_XB);
  const h16* sg = (const h16*)(ws + OFF_SG);
  h16* y = (h16*)(ws + OFF_Y);
  const h16* Wrg = (const h16*)(ws + OFF_WRG);
  const h16* Wig = (const h16*)(ws + OFF_WIG);
  h16* As = (h16*)smem;
  h16* cw_s = (h16*)(smem + 34816);
  h16* cb_s = (h16*)(smem + 36864);
  float* agg = (float*)(smem + 37376);
  h16* Ys = (h16*)(smem + 38400);
  const int tid = ptid(), lane = tid & 63, w = tid >> 6, r = lane & 31, h = lane >> 5;
  const float L2E = 1.44269504f;
  for (int rk = 0; rk * (int)gridDim.x < 640; rk++) {
    const int it = round_item(rk, 640);
    if (it < 0) break;
    const int b = it / 40, n = (it % 40) >> 2, q = it & 3;
    __syncthreads();
    if (tid < 128) {
      cb_s[tid] = (h16)p.conv_b[n * 128 + tid];
#pragma unroll
      for (int k = 0; k < 4; k++) cw_s[k * 128 + tid] = (h16)p.conv_w[k * 1280 + n * 128 + tid];
    }
    h16x8 brg[8], big[8];
    {
      const h16* wr = Wrg + (size_t)(n * 128 + q * 32 + r) * 128 + h * 8;
      const h16* wi = Wig + (size_t)(n * 128 + q * 32 + r) * 128 + h * 8;
#pragma unroll
      for (int ks = 0; ks < 8; ks++) {
        brg[ks] = *(const h16x8*)(wr + ks * 16);
        big[ks] = *(const h16x8*)(wi + ks * 16);
      }
    }
    const int ch = n * 128 + q * 32 + r;
    const float cbr = -L2E * p.b_rg[ch], cbi = -L2E * p.b_ig[ch];
    const float cch2 = -8.f * L2E * log1pf(expf(-p.lam[ch]));
    float hc = 0.f;
    const int cgp = tid & 15, rgp = tid >> 4;
    const h16* src = xb + ((size_t)(b * SEQ) + rgp * 8 - 3) * 1280 + n * 128 + cgp * 8;
    u32x4 xin[11];
#pragma unroll
    for (int j = 0; j < 11; j++) {
      if (rgp == 0 && j < 3) xin[j] = (u32x4){0u, 0u, 0u, 0u};
      else xin[j] = *(const u32x4*)(src + (ptrdiff_t)j * 1280);
    }
    __syncthreads();
    for (int c = 0; c < 16; c++) {
      {
        const h16x8 w0 = *(const h16x8*)(cw_s + 0 * 128 + cgp * 8), w1 = *(const h16x8*)(cw_s + 1 * 128 + cgp * 8);
        const h16x8 w2 = *(const h16x8*)(cw_s + 2 * 128 + cgp * 8), w3 = *(const h16x8*)(cw_s + 3 * 128 + cgp * 8);
        const h16x8 bb = *(const h16x8*)(cb_s + cgp * 8);
#pragma unroll
        for (int o = 0; o < 8; o++) {
          h16x8 a = w0 * __builtin_bit_cast(h16x8, xin[o]) + bb;
          a = w1 * __builtin_bit_cast(h16x8, xin[o + 1]) + a;
          a = w2 * __builtin_bit_cast(h16x8, xin[o + 2]) + a;
          a = w3 * __builtin_bit_cast(h16x8, xin[o + 3]) + a;
          *(h16x8*)(As + (rgp * 8 + o) * 136 + cgp * 8) = a;
        }
      }
      __syncthreads();
      if (c + 1 < 16) {
        const h16* s2 = src + (size_t)(c + 1) * 128 * 1280;
#pragma unroll
        for (int j = 0; j < 11; j++) xin[j] = *(const u32x4*)(s2 + (ptrdiff_t)j * 1280);
      }
      __builtin_amdgcn_sched_barrier(0);
      const int tb = (b * SEQ + c * 128 + w * 32) >> 5, cbk = n * 4 + q;
      const h16* sgp = sg + (((size_t)tb * 40 + cbk) * 64 + lane) * 16;
      const h16x8 sg0 = *(const h16x8*)sgp, sg1 = *(const h16x8*)(sgp + 8);
      f32x16 ar, ai;
#pragma unroll
      for (int i = 0; i < 16; i++) { ar[i] = 0.f; ai[i] = 0.f; }
      {
        const unsigned char* rA = (const unsigned char*)As + (w * 32 + r) * 272 + h * 16;
#pragma unroll
        for (int ks = 0; ks < 8; ks++) {
          const h16x8 a = *(const h16x8*)(rA + ks * 32);
          ar = MFMA(a, brg[ks], ar);
          ai = MFMA(a, big[ks], ai);
        }
      }
      float P[16], H[16], SA[4], SB[4];
#pragma unroll
      for (int gi = 0; gi < 4; gi++) {
        float pp = 1.f, hh = 0.f;
#pragma unroll
        for (int j = 0; j < 4; j++) {
          const int i = gi * 4 + j;
          const int tok = w * 32 + 8 * gi + 4 * h + j;
          const float xc = (float)As[tok * 136 + q * 32 + r];
          const float a1 = fminf(fmaf(ar[i], -L2E, cbr), 60.f), a2 = fminf(fmaf(ai[i], -L2E, cbi), 60.f);
          const float t1 = 1.f + fexp2(a1), t2 = 1.f + fexp2(a2);
          const float inv = frcp(t1 * t2);
          const float rs = t2 * inv, is = t1 * inv;
          const float a = fexp2(cch2 * rs);
          const float om = fmaf(-a, a, 1.f);
          const float bt = __builtin_amdgcn_sqrtf(om) * is * xc;
          hh = a * hh + bt;
          pp = a * pp;
          P[i] = pp;
          H[i] = hh;
        }
        SA[gi] = pp;
        SB[gi] = hh;
      }
      float CA = 1.f, CB = 0.f, inA[4], inB[4];
#pragma unroll
      for (int gi = 0; gi < 4; gi++) {
        const float oa = __shfl_xor(SA[gi], 32), ob = __shfl_xor(SB[gi], 32);
        const float a0 = h ? oa : SA[gi], b0 = h ? ob : SB[gi];
        const float a1 = h ? SA[gi] : oa, b1 = h ? SB[gi] : ob;
        const float ca0 = CA, cb0 = CB;
        CB = a0 * CB + b0;
        CA = a0 * CA;
        inA[gi] = h ? CA : ca0;
        inB[gi] = h ? CB : cb0;
        CB = a1 * CB + b1;
        CA = a1 * CA;
      }
      if (h == 0) {
        agg[(w * 32 + r) * 2] = CA;
        agg[(w * 32 + r) * 2 + 1] = CB;
      }
      __syncthreads();
      float hin = hc, hrun = hc;
#pragma unroll
      for (int w2 = 0; w2 < 4; w2++) {
        const float a = agg[(w2 * 32 + r) * 2], bb = agg[(w2 * 32 + r) * 2 + 1];
        if (w2 == w) hin = hrun;
        hrun = a * hrun + bb;
      }
      hc = hrun;
#pragma unroll
      for (int gi = 0; gi < 4; gi++) {
        const float hs = inA[gi] * hin + inB[gi];
#pragma unroll
        for (int j = 0; j < 4; j++) {
          const int i = gi * 4 + j;
          const int tok = w * 32 + 8 * gi + 4 * h + j;
          const float hv = H[i] + P[i] * hs;
          const float g = (float)(i < 8 ? sg0[i & 7] : sg1[i & 7]);
          Ys[tok * 40 + r] = (h16)(hv * g);
        }
      }
      __syncthreads();
#pragma unroll
      for (int k = 0; k < 2; k++) {
        const int idx = tid + 256 * k, row = idx >> 2, seg = idx & 3;
        *(u32x4*)(y + ((size_t)(b * SEQ + c * 128 + row)) * LDY + n * 128 + q * 32 + seg * 8) = *(const u32x4*)(Ys + row * 40 + seg * 8);
      }
    }
  }
}

DI void phase_res_gemm(const h16* __restrict__ A, int ld, int K, const h16* __restrict__ Bt, const float* __restrict__ res, float* __restrict__ outp, h16* __restrict__ outh, float* __restrict__ ssq,
                       unsigned char* smem) {
  const int lane = ptid() & 63, w = ptid() >> 6, r = lane & 31, h = lane >> 5, wm = w >> 1, wn = w & 1;
  for (int t = vblock(); t < 128 * 8; t += gridDim.x) {
    const int m0 = (t >> 3) * 256, n0 = (t & 7) * 128;
    f32x16 acc[MI][2];
    gemm_mainloop<true>(A, ld, Bt, ld, K, m0, n0, smem, acc);
    const int nb = n0 + wn * 64;
    unsigned char* wl = smem + w * STG_WAVE;
#pragma unroll
    for (int mi = 0; mi < MI; mi++) {
      const int rowb = m0 + wm * 128 + mi * 32;
      const int row = rowb + r;
#pragma unroll
      for (int k = 0; k < 8; k++) {
        const int idx = lane + 64 * k, rr = idx >> 4, sg4 = idx & 15;
        *(float4*)(wl + rr * 272 + sg4 * 16) = *(const float4*)(res + (size_t)(rowb + rr) * 1024 + nb + sg4 * 4);
      }
      stage_fence();
      float sq = 0.f;
      h16x4 ov[2][4];
#pragma unroll
      for (int ni = 0; ni < 2; ni++)
#pragma unroll
        for (int gi = 0; gi < 4; gi++) {
          float4 v = *(const float4*)(wl + r * 272 + (ni * 32 + 8 * gi + 4 * h) * 4);
          v.x += acc[mi][ni][gi * 4 + 0];
          v.y += acc[mi][ni][gi * 4 + 1];
          v.z += acc[mi][ni][gi * 4 + 2];
          v.w += acc[mi][ni][gi * 4 + 3];
          if (outp) *(float4*)(outp + (size_t)row * 1024 + nb + 4 * h + ni * 32 + 8 * gi) = v;
          ov[ni][gi][0] = (h16)v.x; ov[ni][gi][1] = (h16)v.y; ov[ni][gi][2] = (h16)v.z; ov[ni][gi][3] = (h16)v.w;
          sq += v.x * v.x + v.y * v.y + v.z * v.z + v.w * v.w;
        }
      stage_fence();
#pragma unroll
      for (int ni = 0; ni < 2; ni++)
#pragma unroll
        for (int gi = 0; gi < 4; gi++) stage_put(wl, r, h, ni, gi, ov[ni][gi]);
      stage_flush(wl, lane, outh + (size_t)rowb * LD1K + nb, LD1K);
      sq += __shfl_xor(sq, 32);
      if (h == 0) ssq[(size_t)row * 16 + (nb >> 6)] = sq;
    }
    __syncthreads();
  }
}

DI void phase_final(const Params& p, unsigned char* smem) {
  unsigned char* ws = p.ws;
  const h16* A = (const h16*)(ws + OFF_Y2);
  const h16* Bt = (const h16*)(ws + OFF_WOB);
  const h16* __restrict__ res = (const h16*)(ws + OFF_X1H);
  unsigned long long* tags = (unsigned long long*)(ws + OFF_TAGS);
  const int lane = ptid() & 63, w = ptid() >> 6, r = lane & 31, h = lane >> 5, wm = w >> 1, wn = w & 1;
  for (int t = vblock(); t < 128 * 8; t += gridDim.x) {
    const int m0 = (t >> 3) * 256, n0 = (t & 7) * 128;
    f32x16 acc[MI][2];
    gemm_mainloop<true>(A, LD1K, Bt, LD1K, 1024, m0, n0, smem, acc);
    const int nb = n0 + wn * 64;
#pragma unroll
    for (int mi = 0; mi < MI; mi++) {
      const int row = m0 + wm * 128 + mi * 32 + r;
      float sq = 0.f;
      unsigned char* wlr = smem + w * STG_WAVE;
      {
        const h16* rsrc = res + (size_t)(m0 + wm * 128 + mi * 32) * LD1K + nb;
#pragma unroll
        for (int k = 0; k < 4; k++) {
          const int idx = lane + 64 * k, rr = idx >> 3, sg8 = idx & 7;
          *(u32x4*)(wlr + rr * STG_ROW + sg8 * 16) = *(const u32x4*)(rsrc + (size_t)rr * LD1K + sg8 * 8);
        }
        stage_fence();
      }
#pragma unroll
      for (int ni = 0; ni < 2; ni++)
#pragma unroll
        for (int gi = 0; gi < 4; gi++) {
          const h16x4 v = *(const h16x4*)(wlr + r * STG_ROW + (ni * 32 + 8 * gi + 4 * h) * 2);
#pragma unroll
          for (int j = 0; j < 4; j++) acc[mi][ni][gi * 4 + j] += (float)v[j];
#pragma unroll
          for (int j = 0; j < 4; j++) sq += acc[mi][ni][gi * 4 + j] * acc[mi][ni][gi * 4 + j];
        }
      stage_fence();
      sq += __shfl_xor(sq, 32);
      if (h == 0) {
        const unsigned long long pk = (unsigned long long)__float_as_uint(sq) | (1ull << 32);
        __hip_atomic_store(tags + (size_t)row * 16 + (nb >> 6), pk, __ATOMIC_RELAXED, __HIP_MEMORY_SCOPE_AGENT);
      }
    }
#pragma unroll
    for (int mi = 0; mi < MI; mi++) {
      const int row = m0 + wm * 128 + mi * 32 + r;
      float tot = 0.f;
#pragma unroll
      for (int k = 0; k < 8; k++) {
        unsigned long long* tp = tags + (size_t)row * 16 + 8 * h + k;
        unsigned long long v = __hip_atomic_load(tp, __ATOMIC_RELAXED, __HIP_MEMORY_SCOPE_AGENT);
        unsigned spin = 0;
        while ((unsigned)(v >> 32) != 1u && spin < (1u << 22)) {
          __builtin_amdgcn_s_sleep(1);
          v = __hip_atomic_load(tp, __ATOMIC_RELAXED, __HIP_MEMORY_SCOPE_AGENT);
          ++spin;
        }
        tot += __uint_as_float((unsigned)v);
      }
      tot += __shfl_xor(tot, 32);
      const float rinv = rsqrtf(tot * (1.f / 1024.f) + 1e-6f);
      unsigned char* wl = smem + w * STG_WAVE;
#pragma unroll
      for (int ni = 0; ni < 2; ni++)
#pragma unroll
        for (int gi = 0; gi < 4; gi++) {
          const float4 g = *(const float4*)(p.final_norm + nb + 4 * h + ni * 32 + 8 * gi);
          float4 o;
          o.x = acc[mi][ni][gi * 4 + 0] * rinv * g.x;
          o.y = acc[mi][ni][gi * 4 + 1] * rinv * g.y;
          o.z = acc[mi][ni][gi * 4 + 2] * rinv * g.z;
          o.w = acc[mi][ni][gi * 4 + 3] * rinv * g.w;
          *(float4*)(wl + r * 272 + (ni * 32 + 8 * gi + 4 * h) * 4) = o;
        }
      stage_fence();
      const int rowb = m0 + wm * 128 + mi * 32;
#pragma unroll
      for (int k = 0; k < 8; k++) {
        const int idx = lane + 64 * k, rr = idx >> 4, sg4 = idx & 15;
        *(float4*)(p.out + (size_t)(rowb + rr) * 1024 + nb + sg4 * 4) = *(const float4*)(wl + rr * 272 + sg4 * 16);
      }
      stage_fence();
    }
    __syncthreads();
  }
}

DI void phase4(const Params& p, unsigned char* smem) {
  unsigned char* ws = p.ws;
  const h16* A = (const h16*)(ws + OFF_X1H);
  const h16* Bt = (const h16*)(ws + OFF_W4T);
  const float* ssq = (const float*)(ws + OFF_SSQX1);
  h16* ckv = (h16*)(ws + OFF_CKV);
  h16* cq = (h16*)(ws + OFF_CQ);
  h16* sg2 = (h16*)(ws + OFF_SG2);
  h16* Kf = (h16*)(ws + OFF_KF);
  float* ssqkv = (float*)(ws + OFF_SSQKV);
  float* ssqq = (float*)(ws + OFF_SSQQ);
  const float* ct = (const float*)(ws + OFF_COS);
  const float* st = (const float*)(ws + OFF_SIN);
  float* rinv_s = (float*)(smem + GEMM_LDS);
  const int tid = ptid(), lane = tid & 63, w = tid >> 6, r = lane & 31, h = lane >> 5, wm = w >> 1, wn = w & 1;
  for (int base = 0; base < 128 * 14; base += gridDim.x) {
    const int t = base + ((base + (int)gridDim.x <= 128 * 14) ? vblock() : (int)blockIdx.x);
    if (t >= 128 * 14) break;
    const int m0 = (t / 14) * 256, n0 = (t % 14) * 128;
    {
      const float4* sp = (const float4*)(ssq + (size_t)(m0 + tid) * 16);
      float s = 0.f;
#pragma unroll
      for (int i = 0; i < 4; i++) { const float4 v = sp[i]; s += v.x + v.y + v.z + v.w; }
      rinv_s[tid] = rsqrtf(s * (1.f / 1024.f) + 1e-6f);
    }
    f32x16 acc[MI][2];
    gemm_mainloop<true>(A, LD1K, Bt, LD1K, 1024, m0, n0, smem, acc);
    const int nb = n0 + wn * 64;
    const int sub = nb >> 6;
    const int lr0 = wm * 128 + r;
    const int row0 = m0 + lr0;
    unsigned char* wl = smem + w * STG_WAVE;
    const int rowt = m0 + wm * 128;
    if (sub < 10) {
      const bool iskv = sub < 4;
      h16* gb = iskv ? ckv + (size_t)rowt * LDKV + nb : cq + (size_t)rowt * 384 + (nb - 256);
      const int ld = iskv ? LDKV : 384;
      float* sqb = iskv ? ssqkv + (size_t)row0 * 4 + sub : ssqq + (size_t)row0 * 8 + (sub - 4);
      const int sld = iskv ? 4 : 8;
#pragma unroll
      for (int mi = 0; mi < MI; mi++) {
        const float ri = rinv_s[lr0 + mi * 32];
        float sq = 0.f;
#pragma unroll
        for (int ni = 0; ni < 2; ni++)
#pragma unroll
          for (int gi = 0; gi < 4; gi++) {
            h16x4 o;
#pragma unroll
            for (int j = 0; j < 4; j++) {
              const float v = acc[mi][ni][gi * 4 + j] * ri;
              o[j] = (h16)v;
              sq += v * v;
            }
            stage_put(wl, r, h, ni, gi, o);
          }
        stage_flush(wl, lane, gb + (size_t)mi * 32 * ld, ld);
        sq += __shfl_xor(sq, 32);
        if (h == 0) sqb[mi * 32 * sld] = sq;
      }
    } else if (sub < 26) {
      h16* gb = sg2 + (size_t)rowt * 1024 + (nb - 640);
#pragma unroll
      for (int mi = 0; mi < MI; mi++) {
        const float ri = rinv_s[lr0 + mi * 32];
#pragma unroll
        for (int ni = 0; ni < 2; ni++)
#pragma unroll
          for (int gi = 0; gi < 4; gi++) {
            h16x4 o;
#pragma unroll
            for (int j = 0; j < 4; j++) o[j] = (h16)silu_f(acc[mi][ni][gi * 4 + j] * ri);
            stage_put(wl, r, h, ni, gi, o);
          }
        stage_flush(wl, lane, gb + (size_t)mi * 32 * 1024, 1024);
      }
    } else if (sub == 26) {
      const int b = m0 >> 11, s0 = (m0 & 2047) + lr0;
#pragma unroll
      for (int mi = 0; mi < MI; mi++) {
        const float ri = rinv_s[lr0 + mi * 32];
        const int s = s0 + mi * 32;
#pragma unroll
        for (int gi = 0; gi < 4; gi++) {
          const int j0 = 8 * gi + 4 * h;
          const float4 c = *(const float4*)(ct + s * 32 + j0);
          const float4 sn = *(const float4*)(st + s * 32 + j0);
          const float cc[4] = {c.x, c.y, c.z, c.w}, ss[4] = {sn.x, sn.y, sn.z, sn.w};
          h16x4 o1, o2;
#pragma unroll
          for (int j = 0; j < 4; j++) {
            const float x1 = acc[mi][0][gi * 4 + j] * ri, x2 = acc[mi][1][gi * 4 + j] * ri;
            o1[j] = (h16)(x1 * cc[j] - x2 * ss[j]);
            o2[j] = (h16)(x2 * cc[j] + x1 * ss[j]);
          }
          stage_put(wl, r, h, 0, gi, o1);
          stage_put(wl, r, h, 1, gi, o2);
        }
        stage_flush(wl, lane, (h16*)(ws + OFF_KR) + (size_t)(m0 + wm * 128 + mi * 32) * 64, 64);
      }
    }
    __syncthreads();
  }
}

template <bool ISQ>
DI void phase5_part(const Params& p, unsigned char* smem) {
  unsigned char* ws = p.ws;
  const h16* ckv = (const h16*)(ws + OFF_CKV);
  const h16* cq = (const h16*)(ws + OFF_CQ);
  const h16* Wkv = (const h16*)(ws + OFF_W5KV);
  const h16* Wq = (const h16*)(ws + OFF_W5Q);
  const float* ssqkv = (const float*)(ws + OFF_SSQKV);
  const float* ssqq = (const float*)(ws + OFF_SSQQ);
  h16* Kf = (h16*)(ws + OFF_KF);
  h16* Vt = (h16*)(ws + OFF_VT);
  h16* Q = (h16*)(ws + OFF_Q);
  const float* ct = (const float*)(ws + OFF_COS);
  const float* st = (const float*)(ws + OFF_SIN);
  float* rinv_s = (float*)(smem + GEMM_LDS);
  const int tid = ptid(), lane = tid & 63, w = tid >> 6, r = lane & 31, h = lane >> 5, wm = w >> 1, wn = w & 1;
  const float qscale = 0.07216878364870322f * 1.4426950408889634f;
  constexpr int NTT = ISQ ? 12 : 16;
  for (int t = vblock(); t < 128 * NTT; t += gridDim.x) {
    const int mt = t / NTT, nt = (t % NTT) + (ISQ ? 16 : 0);
    const int m0 = mt * 256;
    const int bb = m0 >> 11;
    const int lr0 = wm * 128 + 4 * h;
    const int s0 = (m0 & 2047) + lr0;
    f32x16 acc[MI][2];
    constexpr bool is_q = ISQ;
    const bool is_v = (nt >= 8) && !is_q;
    {
      float rv;
      if (!is_q) {
        const float4 v = *(const float4*)(ssqkv + (size_t)(m0 + tid) * 4);
        rv = rsqrtf((v.x + v.y + v.z + v.w) * (1.f / 256.f) + 1e-6f);
      } else {
        const float4* sp = (const float4*)(ssqq + (size_t)(m0 + tid) * 8);
        const float4 v0 = sp[0], v1 = sp[1];
        rv = rsqrtf((v0.x + v0.y + v0.z + v0.w + v1.x + v1.y) * (1.f / 384.f) + 1e-6f) * qscale;
      }
      rinv_s[tid] = rv;
    }
    const h16* Ap = is_q ? cq : ckv;
    const h16* Bp = is_q ? Wq : Wkv;
    constexpr int Kd = is_q ? 384 : 256;
    constexpr int ldk = is_q ? 384 : LDKV;
    const int n0 = is_q ? (nt - 16) * 128 : nt * 128;
    gemm_mainloop<true, false>(Ap, ldk, Bp, ldk, Kd, m0, n0, smem, acc);
    const int lrw = wm * 128 + r;
    const int sw = (m0 & 2047) + lrw;
    unsigned char* wl = smem + w * STG_WAVE;
    const int st0 = (m0 & 2047) + wm * 128;
    if (!is_v) {
      const int sub = (n0 >> 6) + wn;
      const int hd = is_q ? sub / 3 : nt;
      const int part = is_q ? sub % 3 : wn;
      const int ldo = is_q ? 192 : 128;
      h16* gb = (is_q ? Q : Kf) + ((size_t)(bb * 8 + hd) * SEQ + st0) * ldo + part * 64;
      if (!is_q || part < 2) {
#pragma unroll
        for (int mi = 0; mi < MI; mi++) {
          const float ri = rinv_s[lrw + mi * 32];
#pragma unroll
          for (int ni = 0; ni < 2; ni++)
#pragma unroll
            for (int gi = 0; gi < 4; gi++) {
              h16x4 o;
#pragma unroll
              for (int j = 0; j < 4; j++) o[j] = (h16)(acc[mi][ni][gi * 4 + j] * ri);
              stage_put(wl, r, h, ni, gi, o);
            }
          stage_flush(wl, lane, gb + (size_t)mi * 32 * ldo, ldo);
        }
      } else {
#pragma unroll
        for (int mi = 0; mi < MI; mi++) {
          const float ri = rinv_s[lrw + mi * 32];
          const int s = sw + mi * 32;
#pragma unroll
          for (int gi = 0; gi < 4; gi++) {
            const int j0 = 8 * gi + 4 * h;
            const float4 c = *(const float4*)(ct + s * 32 + j0);
            const float4 sn = *(const float4*)(st + s * 32 + j0);
            const float cc[4] = {c.x, c.y, c.z, c.w}, ss[4] = {sn.x, sn.y, sn.z, sn.w};
            h16x4 o1, o2;
#pragma unroll
            for (int j = 0; j < 4; j++) {
              const float x1 = acc[mi][0][gi * 4 + j] * ri, x2 = acc[mi][1][gi * 4 + j] * ri;
              o1[j] = (h16)(x1 * cc[j] - x2 * ss[j]);
              o2[j] = (h16)(x2 * cc[j] + x1 * ss[j]);
            }
            stage_put(wl, r, h, 0, gi, o1);
            stage_put(wl, r, h, 1, gi, o2);
          }
          stage_flush(wl, lane, gb + (size_t)mi * 32 * 192, 192);
        }
      }
    } else {
#pragma unroll
      for (int mp = 0; mp < 2; mp++) {
#pragma unroll
        for (int m2 = 0; m2 < 2; m2++) {
          const int mi = mp * 2 + m2;
          const float ri = rinv_s[lrw + mi * 32];
          const int t = m2 * 32 + r;
          const int pos = (t & ~15) + 8 * ((t >> 2) & 1) + 4 * ((t >> 3) & 1) + (t & 3);
#pragma unroll
          for (int ni = 0; ni < 2; ni++)
#pragma unroll
            for (int i = 0; i < 16; i++)
              *(h16*)(wl + (ni * 32 + crow(i, h)) * STG_ROW + pos * 2) = (h16)(acc[mi][ni][i] * ri);
        }
        stage_fence();
        const int kt = (st0 + mp * 64) >> 6;
        h16* gv = Vt + (((size_t)(bb * 8 + (nt - 8)) * 32 + kt) * 128 + wn * 64) * 64;
#pragma unroll
        for (int k = 0; k < 8; k++) {
          const int idx = lane + 64 * k, row = idx >> 3, seg = idx & 7;
          *(u32x4*)(gv + row * 64 + seg * 8) = *(const u32x4*)(wl + row * STG_ROW + seg * 16);
        }
        stage_fence();
      }
    }
    __syncthreads();
  }
}

DI void phase5(const Params& p, unsigned char* smem) {
  phase5_part<false>(p, smem);
  phase5_part<true>(p, smem);
}

constexpr int KROW = 400;
constexpr int VROW = 144;
DI void phase6(const Params& p, unsigned char* smem) {
  unsigned char* ws = p.ws;
  const h16* Q = (const h16*)(ws + OFF_Q);
  const h16* Kf = (const h16*)(ws + OFF_KF);
  const h16* Vt = (const h16*)(ws + OFF_VT);
  const h16* sg2 = (const h16*)(ws + OFF_SG2);
  h16* y2 = (h16*)(ws + OFF_Y2);
  unsigned char* Ks = smem;
  unsigned char* Vs = smem + 64 * KROW;
  const int tid = ptid(), lane = tid & 63, w = tid >> 6, r = lane & 31, h = lane >> 5;
  for (int it2 = vblock() * 2; it2 < 2048; it2 += gridDim.x * 2)
  for (int sel = 0; sel < 2; sel++) {
    const int bh = it2 >> 4, xx = (it2 >> 1) & 7;
    const int qb = sel ? xx : 15 - xx;
    const int b = bh >> 3, hd = bh & 7;
    const int qrow = qb * 128 + w * 32 + r;
    h16x8 qf[12];
    {
      const h16* qp = Q + ((size_t)bh * SEQ + qrow) * 192 + h * 8;
#pragma unroll
      for (int ks = 0; ks < 12; ks++) qf[ks] = *(const h16x8*)(qp + ks * 16);
    }
    f32x16 O[4];
#pragma unroll
    for (int dt = 0; dt < 4; dt++)
#pragma unroll
      for (int i = 0; i < 16; i++) O[dt][i] = 0.f;
    float m = -INFINITY, l = 0.f;
    const int nkt = 2 * qb + 2;
    const h16* kbase = Kf + (size_t)bh * SEQ * 128;
    const h16* rbase = (const h16*)(ws + OFF_KR) + (size_t)b * SEQ * 64;
    const h16* vbase = Vt + (size_t)bh * 128 * SEQ;
    u32x4 kst[6], vst[4];
    const h16* kg = kbase + (size_t)(tid >> 4) * 128 + (tid & 15) * 8;
    const h16* rg = rbase + (size_t)(tid >> 3) * 64 + (tid & 7) * 8;
    const h16* vg = vbase + (size_t)(tid >> 3) * 64 + (tid & 7) * 8;
    unsigned char* kw = Ks + (tid >> 4) * KROW + (tid & 15) * 16;
    unsigned char* rw = Ks + (tid >> 3) * KROW + 256 + (tid & 7) * 16;
    unsigned char* vw = Vs + (tid >> 3) * VROW + (tid & 7) * 16;
#pragma unroll
    for (int i = 0; i < 4; i++) kst[i] = *(const u32x4*)(kg + i * 16 * 128);
#pragma unroll
    for (int i = 0; i < 2; i++) kst[4 + i] = *(const u32x4*)(rg + i * 32 * 64);
#pragma unroll
    for (int i = 0; i < 4; i++) vst[i] = *(const u32x4*)(vg + (size_t)i * 32 * 64);
    for (int kt = 0; kt < nkt; kt++) {
#pragma unroll
      for (int i = 0; i < 4; i++) *(u32x4*)(kw + i * 16 * KROW) = kst[i];
#pragma unroll
      for (int i = 0; i < 2; i++) *(u32x4*)(rw + i * 32 * KROW) = kst[4 + i];
#pragma unroll
      for (int i = 0; i < 4; i++) *(u32x4*)(vw + i * 32 * VROW) = vst[i];
      __syncthreads();
      if (kt + 1 < nkt) {
        kg += 64 * 128;
        rg += 64 * 64;
        vg += 8192;
#pragma unroll
        for (int i = 0; i < 4; i++) kst[i] = *(const u32x4*)(kg + i * 16 * 128);
#pragma unroll
        for (int i = 0; i < 2; i++) kst[4 + i] = *(const u32x4*)(rg + i * 32 * 64);
#pragma unroll
        for (int i = 0; i < 4; i++) vst[i] = *(const u32x4*)(vg + (size_t)i * 32 * 64);
      }
#pragma unroll
      for (int half = 0; half < 2; half++) {
        const int sb = (kt - (nkt - 2)) * 2 + half;
        if (sb > w) continue;
        const bool first = (m == -INFINITY);
        const float m_eff = first ? 0.f : m;
        f32x16 sc;
#pragma unroll
        for (int i = 0; i < 16; i++) sc[i] = -m_eff;
        const unsigned char* kr = Ks + (half * 32 + r) * KROW + h * 16;
#pragma unroll
        for (int g = 0; g < 3; g++) {
          h16x8 kf[4];
#pragma unroll
          for (int j = 0; j < 4; j++) kf[j] = *(const h16x8*)(kr + (g * 4 + j) * 32);
#pragma unroll
          for (int j = 0; j < 4; j++) sc = MFMA(kf[j], qf[g * 4 + j], sc);
        }
        if (sb == w) {
#pragma unroll
          for (int i = 0; i < 16; i++)
            if (crow(i, h) > r) sc[i] = -INFINITY;
        }
        float mx = sc[0];
#pragma unroll
        for (int i = 1; i < 16; i++) mx = fmaxf(mx, sc[i]);
        mx = xhalf_max(mx);
        if (__builtin_amdgcn_ballot_w64(first || mx > 8.f) != 0ull) {
          const float d = first ? mx : fmaxf(mx, 0.f);
          const float alpha = first ? 0.f : fexp2(-d);
          m = m_eff + d;
          l *= alpha;
#pragma unroll
          for (int dt = 0; dt < 4; dt++)
#pragma unroll
            for (int i = 0; i < 16; i++) O[dt][i] *= alpha;
#pragma unroll
          for (int i = 0; i < 16; i++) sc[i] -= d;
        }
        float ls = 0.f;
#pragma unroll
        for (int i = 0; i < 16; i++) {
          sc[i] = fexp2(sc[i]);
          ls += sc[i];
        }
        l += ls;
        h16x8 pf0, pf1;
#pragma unroll
        for (int jj = 0; jj < 8; jj++) {
          pf0[jj] = (h16)sc[jj];
          pf1[jj] = (h16)sc[8 + jj];
        }
        const unsigned char* vr = Vs + r * VROW + h * 16 + half * 64;
#pragma unroll
        for (int dp = 0; dp < 2; dp++) {
          h16x8 vf[4];
#pragma unroll
          for (int j = 0; j < 4; j++) vf[j] = *(const h16x8*)(vr + (dp * 2 + (j >> 1)) * 32 * VROW + (j & 1) * 32);
#pragma unroll
          for (int j = 0; j < 4; j++) O[dp * 2 + (j >> 1)] = MFMA(vf[j], (j & 1) ? pf1 : pf0, O[dp * 2 + (j >> 1)]);
        }
      }
      __syncthreads();
    }
    l += __shfl_xor(l, 32);
    const float inv = 1.f / l;
    {
      unsigned char* wl = smem + w * STG_WAVE;
      const int rowb = b * SEQ + qb * 128 + w * 32;
#pragma unroll
      for (int dp = 0; dp < 2; dp++) {
        const h16* gsrc = sg2 + (size_t)rowb * 1024 + hd * 128 + dp * 64;
#pragma unroll
        for (int k = 0; k < 4; k++) {
          const int idx = lane + 64 * k, rr = idx >> 3, sg8 = idx & 7;
          *(u32x4*)(wl + rr * STG_ROW + sg8 * 16) = *(const u32x4*)(gsrc + (size_t)rr * 1024 + sg8 * 8);
        }
        stage_fence();
        h16x4 ov[2][4];
#pragma unroll
        for (int ni = 0; ni < 2; ni++)
#pragma unroll
          for (int gi = 0; gi < 4; gi++) {
            const h16x4 gt = *(const h16x4*)(wl + r * STG_ROW + (ni * 32 + 8 * gi + 4 * h) * 2);
#pragma unroll
            for (int jj = 0; jj < 4; jj++) ov[ni][gi][jj] = (h16)(O[dp * 2 + ni][gi * 4 + jj] * inv * (float)gt[jj]);
          }
        stage_fence();
#pragma unroll
        for (int ni = 0; ni < 2; ni++)
#pragma unroll
          for (int gi = 0; gi < 4; gi++) stage_put(wl, r, h, ni, gi, ov[ni][gi]);
        stage_flush(wl, lane, y2 + (size_t)rowb * LD1K + hd * 128 + dp * 64, LD1K);
      }
    }
    __syncthreads();
  }
}

DI void phase8(const Params& p) {
  const float* ssq = (const float*)(p.ws + OFF_SSQO);
  const int tid = ptid(), lane = tid & 63;
  const int nw = gridDim.x * 4;
  for (int row = blockIdx.x * 4 + (tid >> 6); row < M_TOK; row += nw) {
    const float4* sp = (const float4*)(ssq + (size_t)row * 16);
    float s = 0.f;
#pragma unroll
    for (int i = 0; i < 4; i++) { const float4 v = sp[i]; s += v.x + v.y + v.z + v.w; }
    const float rinv = rsqrtf(s * (1.f / 1024.f) + 1e-6f);
    const float4* xr = (const float4*)((const float*)(p.ws + OFF_X2) + (size_t)row * 1024);
    float4* orow = (float4*)(p.out + (size_t)row * 1024);
#pragma unroll
    for (int i = 0; i < 4; i++) {
      float4 v = xr[lane + 64 * i];
      const float4 g = ((const float4*)p.final_norm)[lane + 64 * i];
      v.x *= rinv * g.x; v.y *= rinv * g.y; v.z *= rinv * g.z; v.w *= rinv * g.w;
      orow[lane + 64 * i] = v;
    }
  }
}

#define XB_TMO      128
#define XB_XCNT(j)  (256  + 64 * (j))
#define XB_XSUB(j)  (1280 + 64 * (j))
#define XB_XGEN(j)  (2304 + 64 * (j))
#define XB_TOP      3328
#define XB_TOPGEN   3392
#define XCD_BAR_WORDS 3456
#define XB_SPIN_CAP (1u << 18)
#define LAS __attribute__((address_space(3)))
DI unsigned xb_ld(unsigned* p) { return __hip_atomic_load(p, __ATOMIC_RELAXED, __HIP_MEMORY_SCOPE_AGENT); }
DI unsigned xb_add(unsigned* p, unsigned v) { return __hip_atomic_fetch_add(p, v, __ATOMIC_RELAXED, __HIP_MEMORY_SCOPE_AGENT); }
DI unsigned xb_xcc_id() { return (unsigned)__builtin_amdgcn_s_getreg((3 << 11) | 20) & 0xFu; }
#define XB_SPIN(cond, bar) do { unsigned _sp = 0; while (cond) { __builtin_amdgcn_s_sleep(1); \
    if ((++_sp & 255u) == 0u) { if (xb_ld(&(bar)[XB_TMO])) break; if (_sp > XB_SPIN_CAP) { atomicAdd(&(bar)[XB_TMO], 1u); break; } } } } while (0)
struct XcdBarrier { unsigned* bar; unsigned x; volatile LAS unsigned* st; };
DI XcdBarrier xcd_barrier_post(unsigned* bar, volatile LAS unsigned* st) {
  XcdBarrier b; b.bar = bar; b.x = xb_xcc_id(); b.st = st;
  if (threadIdx.x == 0) (void)xb_add(&bar[XB_XCNT(b.x)], 1u);
  return b;
}
DI void xcd_barrier_complete(unsigned* bar, unsigned x, unsigned& nloc, unsigned& nx) {
  const unsigned G = gridDim.x;
  unsigned sum, cnt, mine, sp = 0u;
  for (;;) {
    sum = 0u; cnt = 0u; mine = 0u;
#pragma unroll
    for (unsigned j = 0; j < 16; ++j) { const unsigned c = xb_ld(&bar[XB_XCNT(j)]); sum += c; cnt += (c > 0u) ? 1u : 0u; mine = (j == x) ? c : mine; }
    if (sum == G) break;
    __builtin_amdgcn_s_sleep(1);
    if ((++sp & 255u) == 0u) { if (xb_ld(&bar[XB_TMO])) break; if (sp > XB_SPIN_CAP) { atomicAdd(&bar[XB_TMO], 1u); break; } }
  }
  nloc = mine > 0u ? mine : 1u; nx = cnt > 0u ? cnt : 1u;
}
DI void xcd_barrier(const XcdBarrier& b) {
  asm volatile("s_waitcnt vmcnt(0)" ::: "memory");
  __syncthreads();
  if (threadIdx.x == 0) {
    unsigned* bar = b.bar;
    __builtin_amdgcn_s_waitcnt(0);
    unsigned nloc = b.st[0], nx = b.st[1];
    if (nloc == 0u) { xcd_barrier_complete(bar, b.x, nloc, nx); b.st[0] = nloc; b.st[1] = nx; }
    const unsigned old = xb_add(&bar[XB_XSUB(b.x)], 1u);
    const unsigned gen = old / nloc;
    if (old + 1u == (gen + 1u) * nloc) {
      __builtin_amdgcn_fence(__ATOMIC_RELEASE, "agent");
      asm volatile("s_waitcnt vmcnt(0)" ::: "memory");
      const unsigned og = xb_add(&bar[XB_TOP], 1u);
      const unsigned tg = og / nx;
      if (og + 1u == (tg + 1u) * nx) xb_add(&bar[XB_TOPGEN], 1u);
      else XB_SPIN(xb_ld(&bar[XB_TOPGEN]) == tg, bar);
      __builtin_amdgcn_fence(__ATOMIC_ACQUIRE, "agent");
      xb_add(&bar[XB_XGEN(b.x)], 1u);
      asm volatile("s_waitcnt vmcnt(0)" ::: "memory");
    } else {
      XB_SPIN(xb_ld(&bar[XB_XGEN(b.x)]) == gen, bar);
      __builtin_amdgcn_fence(__ATOMIC_ACQUIRE, "agent");
      asm volatile("s_waitcnt vmcnt(0)" ::: "memory");
    }
  }
  __syncthreads();
}

constexpr int SMEM_BYTES = 56320;
__global__ void __launch_bounds__(256, 2) yoco_fwd(Params p) {
  __shared__ __attribute__((aligned(16))) unsigned char smem[SMEM_BYTES];
  __shared__ uint4 xb_words;
  unsigned char* ws = p.ws;
  if (threadIdx.x == 0) xb_words = make_uint4(0u, 0u, 0u, 0u);
  __syncthreads();
  const XcdBarrier xb = xcd_barrier_post((unsigned*)(ws + OFF_BAR), (volatile LAS unsigned*)&xb_words);
  if (p.out == nullptr) {
    const unsigned long long mg = *(const volatile unsigned long long*)((const char*)__builtin_amdgcn_implicitarg_ptr() + 88);
    if (mg == 1ull) ((volatile unsigned*)(ws + OFF_BAR))[XB_TMO] = 1u;
  }
#ifndef DUP
#define DUP 0
#endif
#ifndef PHM
#define PHM 0xfff
#endif
#define RUNP(bit, call) { if (PHM & bit) { call; } xcd_barrier(xb); if (DUP & bit) { call; xcd_barrier(xb); } }
  RUNP(1, phase0(p, smem))
  RUNP(2, phase1(p, smem))
  RUNP(4, phase2(p, smem))
  RUNP(8, phase_res_gemm((const h16*)(ws + OFF_Y), LDY, 1280, (const h16*)(ws + OFF_WOA), p.x, nullptr, (h16*)(ws + OFF_X1H), (float*)(ws + OFF_SSQX1), smem))
  RUNP(16, phase4(p, smem))
  RUNP(32, phase5(p, smem))
  RUNP(64, phase6(p, smem))
  if (PHM & 128) phase_final(p, smem);
}

extern "C" void kernel_launch(void* const* d_in, const int* in_sizes, int n_in, void* d_out, int out_size, void* d_ws,
                              size_t ws_size, hipStream_t stream) {
  static int grid_blocks = 0;
  static int cus_s = 0;
  if (!grid_blocks) {
    int dev = 0, cus = 0;
    (void)hipGetDevice(&dev);
    (void)hipDeviceGetAttribute(&cus, hipDeviceAttributeMultiprocessorCount, dev);
    if (cus < 8) cus = 256;
    cus -= cus % 8;
    cus_s = cus;
    grid_blocks = cus * 2;
  }
  Params p{};
  const float** pp = (const float**)&p;
  for (int i = 0; i < 22; i++) pp[i] = (const float*)d_in[i];
  p.out = (float*)d_out;
  p.ws = (unsigned char*)d_ws;
  (void)hipMemsetAsync((unsigned char*)d_ws + OFF_BAR, 0, XCD_BAR_WORDS * sizeof(unsigned), stream);
  void* args[] = {&p};
  hipError_t e = hipLaunchCooperativeKernel((void*)yoco_fwd, dim3(grid_blocks), dim3(256), args, 0, stream);
  if (e != hipSuccess && grid_blocks != cus_s) {
    (void)hipGetLastError();
    grid_blocks = cus_s;
    e = hipLaunchCooperativeKernel((void*)yoco_fwd, dim3(grid_blocks), dim3(256), args, 0, stream);
  }
  if (e != hipSuccess) fprintf(stderr, "cooperative launch failed: %s (grid %d)\n", hipGetErrorString(e), grid_blocks);
}
```
